# Optimizing an MI355X kernel written in HIP

```python
import jax, jax.numpy as jnp
from jax import lax
import numpy as np

D_MODEL = 1024
BATCH = 2
SEQ = 8192
DEPTH = 1

N_META = 16
CHUNK = 128
META_PAD = CHUNK - N_META
RET_HEADS = 4
RET_DK = 128
RET_DV = 256
ATT_HEADS = 8
ATT_GROUPS = 2
ATT_HD = 128
WINDOW = 128
ROPE_THETA = 10000.0
EPS = 1e-6
NEG_INF = -1e30
RET_QK = RET_HEADS * RET_DK
RET_V = RET_HEADS * RET_DV
ATT_Q = ATT_HEADS * ATT_HD
ATT_KV = ATT_GROUPS * ATT_HD
IN_SPLIT = (RET_QK, RET_QK, RET_V, RET_V, ATT_Q, ATT_KV, ATT_KV, ATT_Q, D_MODEL, D_MODEL)
D_IN = 2 * RET_QK + 2 * RET_V + 2 * ATT_Q + 2 * ATT_KV + 2 * D_MODEL

kernel_name = "hybrid_retention_swa_encoder_block"


def _rms_norm(x, w):
    xf = x.astype(jnp.float32)
    y = xf * lax.rsqrt(jnp.mean(xf * xf, axis=-1, keepdims=True) + EPS)
    return (y * w.astype(jnp.float32)).astype(x.dtype)


def _split_in(z):
    parts = []
    start = 0
    for size in IN_SPLIT:
        parts.append(z[..., start:start + size])
        start += size
    return parts


def _rotary(t, pos):
    d = t.shape[-1]
    half = d // 2
    inv = ROPE_THETA ** (-jnp.arange(half, dtype=jnp.float32) * 2.0 / d)
    ang = pos[:, None] * inv[None, :]
    cos = jnp.cos(ang)[None, :, None, :]
    sin = jnp.sin(ang)[None, :, None, :]
    tf = t.astype(jnp.float32)
    t1, t2 = tf[..., :half], tf[..., half:]
    return jnp.concatenate([t1 * cos - t2 * sin, t2 * cos + t1 * sin], axis=-1)


def _pad_front(t):
    return jnp.pad(t, ((0, 0), (META_PAD, 0)) + ((0, 0),) * (t.ndim - 2))


def _retention_direction(q, k, v, log_gamma, strict):
    B, L, H, DK = q.shape
    DV = v.shape[-1]
    nc = L // CHUNK
    q = q.reshape(B, nc, CHUNK, H, DK)
    k = k.reshape(B, nc, CHUNK, H, DK)
    v = v.reshape(B, nc, CHUNK, H, DV)
    idx = jnp.arange(CHUNK, dtype=jnp.float32)
    rel = idx[:, None] - idx[None, :]
    vis = (rel > 0) if strict else (rel >= 0)
    decay = jnp.where(vis[None], jnp.exp(jnp.where(vis, rel, 0.0)[None] * log_gamma[:, None, None]), 0.0)
    s = jnp.einsum("bnihd,bnjhd->bnhij", q, k) * decay[None, None]
    inner = jnp.einsum("bnhij,bnjhv->bnihv", s, v)
    k_decay = jnp.exp((CHUNK - 1 - idx)[:, None] * log_gamma[None, :])
    kv = jnp.einsum("bnjhd,bnjhv->bnhdv", k * k_decay[None, None, :, :, None], v)
    chunk_decay = jnp.exp(CHUNK * log_gamma)[None, :, None, None]

    def step(state, kv_c):
        return chunk_decay * state + kv_c, state

    _, s_prev = lax.scan(step, jnp.zeros((B, H, DK, DV), jnp.float32), jnp.moveaxis(kv, 1, 0))
    s_prev = jnp.moveaxis(s_prev, 0, 1)
    q_decay = jnp.exp((idx + 1.0)[:, None] * log_gamma[None, :])
    cross = jnp.einsum("bnihd,bnhdv->bnihv", q * q_decay[None, None, :, :, None], s_prev)
    return (inner + cross).reshape(B, L, H, DV)


def _bidirectional_retention(q, k, v, log_gamma_f, log_gamma_b):
    fwd = _retention_direction(q, k, v, log_gamma_f, False)
    flip = lambda t: jnp.flip(t, axis=1)
    bwd = flip(_retention_direction(flip(q), flip(k), flip(v), log_gamma_b, True))
    return fwd + bwd


def _windowed_sink_attention(q, k, v, sink):
    B, Lp, H, hd = q.shape
    G = k.shape[2]
    R = H // G
    nb = Lp // CHUNK
    qb = q.reshape(B, nb, CHUNK, G, R, hd)

    def band(t):
        tp = jnp.pad(t, ((0, 0), (CHUNK, CHUNK), (0, 0), (0, 0))).reshape(B, nb + 2, CHUNK, G, hd)
        return jnp.concatenate([tp[:, :-2], tp[:, 1:-1], tp[:, 2:]], axis=2)

    kb, vb = band(k), band(v)
    km, vm = k[:, META_PAD:CHUNK], v[:, META_PAD:CHUNK]
    qpos = jnp.arange(Lp).reshape(nb, CHUNK)
    kpos = (jnp.arange(nb)[:, None] - 1) * CHUNK + jnp.arange(3 * CHUNK)[None, :]
    kp = kpos[:, None, :]
    ok = (jnp.abs(qpos[:, :, None] - kp) <= WINDOW) & (kp >= CHUNK) & (kp < Lp)
    scale = ATT_HD ** -0.5
    s_band = jnp.einsum("bnqgrd,bnkgd->bngrqk", qb, kb) * scale
    s_band = jnp.where(ok[None, :, None, None], s_band, NEG_INF)
    s_meta = jnp.einsum("bnqgrd,bmgd->bngrqm", qb, km) * scale
    s = jnp.concatenate([s_band, s_meta], axis=-1)
    sink_l = sink.astype(jnp.float32).reshape(G, R)[None, None, :, :, None, None]
    m = jnp.maximum(jnp.max(s, axis=-1, keepdims=True), sink_l)
    p = jnp.exp(s - m)
    p = p / (jnp.sum(p, axis=-1, keepdims=True) + jnp.exp(sink_l - m))
    o = (jnp.einsum("bngrqk,bnkgd->bnqgrd", p[..., :3 * CHUNK], vb)
         + jnp.einsum("bngrqm,bmgd->bnqgrd", p[..., 3 * CHUNK:], vm))
    return o.reshape(B, Lp, H, hd)


def _hybrid_layer(h, pre_w, w_in, dec_f, dec_b, ret_nw, w_rb, sink, w_ab, w_o, post_w):
    B, T, _ = h.shape
    u = _rms_norm(h, pre_w)
    z = u @ w_in
    rq, rk, rv, rg, aq, ak, av, ag, gr, ga = _split_in(z)
    pos = jnp.arange(T, dtype=jnp.float32)

    rq = _pad_front(_rotary(rq.reshape(B, T, RET_HEADS, RET_DK), pos))
    rk = _pad_front(_rotary(rk.reshape(B, T, RET_HEADS, RET_DK), pos) * (RET_DK ** -0.5))
    rv = _pad_front(rv.reshape(B, T, RET_HEADS, RET_DV).astype(jnp.float32))
    lg_f = jax.nn.log_sigmoid(dec_f.astype(jnp.float32))
    lg_b = jax.nn.log_sigmoid(dec_b.astype(jnp.float32))
    o_r = _bidirectional_retention(rq, rk, rv, lg_f, lg_b)[:, META_PAD:]
    mu = jnp.mean(o_r, axis=-1, keepdims=True)
    var = jnp.mean(jnp.square(o_r - mu), axis=-1, keepdims=True)
    o_r = ((o_r - mu) * lax.rsqrt(var + EPS)).reshape(B, T, RET_V)
    o_r = o_r * ret_nw.astype(jnp.float32) * jax.nn.silu(rg.astype(jnp.float32))
    y_r = o_r.astype(h.dtype) @ w_rb

    aq = _pad_front(_rotary(aq.reshape(B, T, ATT_HEADS, ATT_HD), pos))
    ak = _pad_front(_rotary(ak.reshape(B, T, ATT_GROUPS, ATT_HD), pos))
    av = _pad_front(av.reshape(B, T, ATT_GROUPS, ATT_HD).astype(jnp.float32))
    o_a = _windowed_sink_attention(aq, ak, av, sink)[:, META_PAD:].reshape(B, T, ATT_Q)
    o_a = o_a * jax.nn.silu(ag.astype(jnp.float32))
    y_a = o_a.astype(h.dtype) @ w_ab

    mix = jax.nn.sigmoid(gr) * y_r + jax.nn.sigmoid(ga) * y_a
    out = mix @ w_o
    return h + _rms_norm(out, post_w)


def setup_inputs(seed: int = 0) -> dict:
    key = jax.random.key(seed)
    ks = jax.random.split(key, 12)
    f32 = jnp.float32
    nrm = jax.random.normal
    base_decay = jnp.log(2.0 ** (5.0 + jnp.arange(RET_HEADS, dtype=f32)) - 1.0)
    return {
        "x": nrm(ks[0], (BATCH, SEQ, D_MODEL), f32),
        "meta_tokens": nrm(ks[1], (N_META, D_MODEL), f32),
        "pre_norm_w": 1.0 + 0.02 * nrm(ks[2], (DEPTH, D_MODEL), f32),
        "w_in": nrm(ks[3], (DEPTH, D_MODEL, D_IN), f32) * D_MODEL ** -0.5,
        "ret_decay_fwd": base_decay[None] + 0.1 * nrm(ks[4], (DEPTH, RET_HEADS), f32),
        "ret_decay_bwd": base_decay[None] + 0.1 * nrm(ks[5], (DEPTH, RET_HEADS), f32),
        "ret_norm_w": 1.0 + 0.02 * nrm(ks[6], (DEPTH, RET_V), f32),
        "w_ret_branch": nrm(ks[7], (DEPTH, RET_V, D_MODEL), f32) * RET_V ** -0.5,
        "attn_sink": 0.5 * nrm(ks[8], (DEPTH, ATT_HEADS), f32),
        "w_attn_branch": nrm(ks[9], (DEPTH, ATT_Q, D_MODEL), f32) * ATT_Q ** -0.5,
        "w_out": nrm(ks[10], (DEPTH, D_MODEL, D_MODEL), f32) * D_MODEL ** -0.5,
        "post_norm_w": 1.0 + 0.02 * nrm(ks[11], (DEPTH, D_MODEL), f32),
    }


def reference(x, meta_tokens, pre_norm_w, w_in, ret_decay_fwd, ret_decay_bwd, ret_norm_w,
              w_ret_branch, attn_sink, w_attn_branch, w_out, post_norm_w):
    B = x.shape[0]
    meta = jnp.broadcast_to(meta_tokens.astype(x.dtype)[None], (B, N_META, x.shape[-1]))
    h = jnp.concatenate([meta, x], axis=1)
    for layer in range(DEPTH):
        h = _hybrid_layer(h, pre_norm_w[layer], w_in[layer], ret_decay_fwd[layer], ret_decay_bwd[layer],
                          ret_norm_w[layer], w_ret_branch[layer], attn_sink[layer], w_attn_branch[layer],
                          w_out[layer], post_norm_w[layer])
    return h[:, N_META:]
```

```cpp
#include <hip/hip_runtime.h>
#include <hip/hip_cooperative_groups.h>
#include <cstdio>
#include <cstdint>
namespace cg = cooperative_groups;

#ifndef MK_N_LAUNCHES
#define MK_N_LAUNCHES 1
#endif

#define LAS __attribute__((address_space(3)))
#define DI __device__ __forceinline__
typedef unsigned short bf16_t;
typedef short bf16x8 __attribute__((ext_vector_type(8)));
typedef float f32x4 __attribute__((ext_vector_type(4)));
typedef float f32x2 __attribute__((ext_vector_type(2)));
typedef unsigned u32x4 __attribute__((ext_vector_type(4)));
typedef unsigned u32x2 __attribute__((ext_vector_type(2)));

constexpr int DM = 1024, NB = 2, SEQ = 8192, NMETA = 16, TT = SEQ + NMETA;
constexpr int CH = 128, MPAD = CH - NMETA;
constexpr int LP = TT + MPAD;
constexpr int NCH = LP / CH;
constexpr int MP = NB * LP;
constexpr int MS = NB * SEQ;
constexpr int RH = 4, RDK = 128, RDV = 256, AH = 8, AG = 2, AHD = 128;
constexpr int DIN = 7680, NA = 3584, NGATE = 4096;
constexpr float EPSF = 1e-6f;
constexpr float LOG2E = 1.4426950408889634f;

constexpr size_t OFF_RQ = 0;
constexpr size_t OFF_RK = OFF_RQ + (size_t)MP * 512 * 2;
constexpr size_t OFF_RV = OFF_RK + (size_t)MP * 512 * 2;
constexpr size_t OFF_AQ = OFF_RV + (size_t)MP * 1024 * 2;
constexpr size_t OFF_AK = OFF_AQ + (size_t)MP * 1024 * 2;
constexpr size_t OFF_AV = OFF_AK + (size_t)MP * 256 * 2;
constexpr size_t OFF_KVS = OFF_AV + (size_t)MP * 256 * 2;
constexpr size_t KVS_BYTES = (size_t)2 * NB * NCH * RH * 32768 * 2;
constexpr size_t OFF_OR = OFF_KVS + KVS_BYTES;
constexpr size_t OFF_OA = OFF_OR + (size_t)MS * 1024 * 2;
constexpr size_t WS_END = OFF_OA + (size_t)MS * 1024 * 2;
constexpr size_t OFF_SGR = OFF_RQ, OFF_SGA = OFF_RQ + (size_t)MS * 1024 * 2;
constexpr size_t OFF_MIX = OFF_AQ;
constexpr size_t OFF_PART = OFF_KVS;
constexpr size_t OFF_OUT = OFF_OR;
static_assert(OFF_SGA + (size_t)MS * 1024 * 2 <= OFF_AQ, "gate overlay");
static_assert((size_t)MS * 1024 * 4 <= KVS_BYTES, "part overlay");
static_assert(WS_END <= 268435456ull, "ws");
constexpr size_t DO_U = 0;
constexpr size_t DO_WIN = DO_U + (size_t)MP * 1024 * 2;
constexpr size_t DO_WRB = DO_WIN + (size_t)DIN * 1024 * 2;
constexpr size_t DO_WAB = DO_WRB + (size_t)1024 * 1024 * 2;
constexpr size_t DO_WO = DO_WAB + (size_t)1024 * 1024 * 2;
constexpr size_t DO_CS = DO_WO + (size_t)1024 * 1024 * 2;
static_assert(DO_CS + (size_t)TT * 64 * 8 <= (size_t)MS * 1024 * 4, "d_out scratch");

constexpr int LDS_BYTES = 147456;
constexpr int LDT = 136;

typedef __bf16 bf16v2 __attribute__((ext_vector_type(2)));
DI unsigned cvt_pk_bf16(float lo, float hi) { const f32x2 v = {lo, hi}; const bf16v2 b = __builtin_convertvector(v, bf16v2); return __builtin_bit_cast(unsigned, b); }
DI float bf2f(unsigned short b) { return __uint_as_float(((unsigned)b) << 16); }
DI float bflo(unsigned w) { return __uint_as_float(w << 16); }
DI float bfhi(unsigned w) { return __uint_as_float(w & 0xffff0000u); }
DI float wave_sum(float v) {
#pragma unroll
    for (int o = 1; o < 64; o <<= 1) v += __shfl_xor(v, o);
    return v;
}
DI f32x4 mfma16(bf16x8 a, bf16x8 b, f32x4 c) { return __builtin_amdgcn_mfma_f32_16x16x32_bf16(a, b, c, 0, 0, 0); }
#define LDS_WAIT() asm volatile("s_waitcnt lgkmcnt(0)" ::: "memory")

namespace pg8 {
constexpr int BM = 256, BK = 64, HALF = 128, HTB = HALF * BK * 2, STAGE_BYTES = 8 * HTB, NXCD = 8, WGM = 8;
DI int lds_byte(int r, int c) { const int st = (r >> 4) * 2 + (c >> 5), rr = r & 15, cc = c & 31, ob = rr * 64 + cc * 2; return st * 1024 + (ob ^ (((ob >> 9) & 1) << 5)); }
DI void stage_rc(int b, int& R, int& C) { const int st = b / 1024, sb = b % 1024, swz = sb ^ (((sb >> 9) & 1) << 5); R = (st >> 1) * 16 + swz / 64; C = (st & 1) * 32 + (swz % 64) / 2; }
struct Unit { int pm, pn; };
struct Gemm { const bf16_t* A; const bf16_t* Bt; int M, N, K, amode; };
DI size_t a_row0(const Gemm& g, int pm) { return g.amode ? (size_t)((pm >> 5) * LP + 128 + (pm & 31) * 256) : (size_t)pm * 256; }
struct StaticOrder {
    int nM, nN, nwg, G, c;
    DI void init(int M, int N, int G_, int c_) { nM = M / BM; nN = N / BM; nwg = nM * nN; G = G_; c = c_; }
    DI bool next(int i, Unit& u) const {
        const long L = (long)i * G + c; if (L >= nwg) return false;
        int wgid = (int)L; { const int q = nwg / NXCD, r = nwg % NXCD, xcd = wgid % NXCD, off = wgid / NXCD; wgid = (xcd < r ? xcd * (q + 1) : r * (q + 1) + (xcd - r) * q) + off; }
        const int nig = WGM * nN, gid = wgid / nig, fm = gid * WGM, gsz = (nM - fm) < WGM ? (nM - fm) : WGM;
        u.pm = fm + ((wgid % nig) % gsz); u.pn = (wgid % nig) / gsz; return true;
    }
};
template <class Epi, bool ALIGN_EPI>
DI void gemm_phase(LAS unsigned char* lds, const Gemm g, const StaticOrder& S, const Epi& E) {
    const int tid = threadIdx.x, wid = __builtin_amdgcn_readfirstlane(tid >> 6), lane = tid & 63, wr = wid >> 2, wc = wid & 3, fr = lane & 15, fq = lane >> 4;
    const int K = g.K, nt = K / BK;
    unsigned voffA[2];
#pragma unroll
    for (int i = 0; i < 2; ++i) { int R, C; stage_rc(tid * 16 + i * 8192, R, C); voffA[i] = (unsigned)(R * K + C) * 2u; }
    const size_t kstep = (size_t)(BK * 2);
    const size_t hstep = (size_t)HALF * K * 2;
    const size_t tstep = 2 * hstep;
    const size_t rowb = (size_t)K * 2;
    const unsigned ldsw = (unsigned)wid * 1024u;
    const int aoff = lds_byte(wr * 64 + fr, fq * 8), boff = lds_byte(wc * 32 + fr, fq * 8);
#define PG8_SA(b, h) (((b) * 2 + (h)) * HTB)
#define PG8_SB(b, h) ((4 + (b) * 2 + (h)) * HTB)
#define PG8_STAGE(bufoff, gbase, voff) do { _Pragma("unroll") for (int _i = 0; _i < 2; ++_i) \
        __builtin_amdgcn_global_load_lds((const unsigned*)((const char*)(gbase) + (voff)[_i]), (LAS unsigned*)(lds + (bufoff) + ldsw + _i * 8192), 16, 0, 0); } while (0)
#define PG8_LDA(dst, b, h) do { _Pragma("unroll") for (int m = 0; m < 4; ++m) _Pragma("unroll") for (int k = 0; k < 2; ++k) dst[m][k] = *(const LAS bf16x8*)(lds + PG8_SA(b, h) + aoff + m * 2048 + k * 1024); } while (0)
#define PG8_LDB(dst, b, h) do { _Pragma("unroll") for (int n = 0; n < 2; ++n) _Pragma("unroll") for (int k = 0; k < 2; ++k) dst[n][k] = *(const LAS bf16x8*)(lds + PG8_SB(b, h) + boff + n * 2048 + k * 1024); } while (0)
#define PG8_MMA(ai, bj, At, Bt) do { __builtin_amdgcn_s_setprio(1); _Pragma("unroll") for (int m = 0; m < 4; ++m) _Pragma("unroll") for (int n = 0; n < 2; ++n) _Pragma("unroll") for (int k = 0; k < 2; ++k) \
        acc[ai][bj][m][n] = __builtin_amdgcn_mfma_f32_16x16x32_bf16(Bt[n][k], At[m][k], acc[ai][bj][m][n], 0, 0, 0); __builtin_amdgcn_s_setprio(0); } while (0)
#define PG8_WAIT_V(n) asm volatile("s_waitcnt vmcnt(" #n ")" ::: "memory")
#define PG8_WAIT_L(n) asm volatile("s_waitcnt lgkmcnt(" #n ")" ::: "memory")
#define PG8_BAR __builtin_amdgcn_s_barrier()
#define PG8_SCHED __builtin_amdgcn_sched_barrier(0)
    Unit cur, nxt; int ui = 0;
    if (!S.next(0, cur)) return;
    f32x4 acc[2][2][4][2];
#pragma unroll
    for (int a = 0; a < 2; ++a)
#pragma unroll
        for (int b = 0; b < 2; ++b)
#pragma unroll
            for (int m = 0; m < 4; ++m)
#pragma unroll
                for (int n = 0; n < 2; ++n) acc[a][b][m][n] = (f32x4){0.f, 0.f, 0.f, 0.f};
    bf16x8 At[4][2], B0[2][2], B1[2][2];
    const char* cA = (const char*)g.A + a_row0(g, cur.pm) * rowb; const char* cB = (const char*)g.Bt + (size_t)cur.pn * tstep;
    PG8_STAGE(PG8_SB(0, 0), cB, voffA); PG8_STAGE(PG8_SB(0, 1), cB + hstep, voffA); PG8_STAGE(PG8_SA(0, 0), cA, voffA); PG8_STAGE(PG8_SA(0, 1), cA + hstep, voffA);
    if (wr == 1) PG8_BAR;
    PG8_WAIT_V(2); PG8_BAR;
    PG8_STAGE(PG8_SB(1, 0), cB + kstep, voffA); PG8_STAGE(PG8_SA(1, 0), cA + kstep, voffA); PG8_STAGE(PG8_SB(1, 1), cB + hstep + kstep, voffA);
    PG8_WAIT_V(6); PG8_BAR;
    for (;;) {
        const bool has_next = S.next(ui + 1, nxt);
        const char* nA = has_next ? (const char*)g.A + a_row0(g, nxt.pm) * rowb : cA; const char* nB = has_next ? (const char*)g.Bt + (size_t)nxt.pn * tstep : cB;
        for (int t = 0; t < nt; t += 2) {
            const bool last = (t == nt - 2);
            const char* a1 = cA + (size_t)(t + 1) * kstep;
            const char* a2 = last ? nA : cA + (size_t)(t + 2) * kstep; const char* b2 = last ? nB : cB + (size_t)(t + 2) * kstep;
            const char* a3 = a2 + kstep; const char* b3 = b2 + kstep;
            PG8_LDB(B0, 0, 0); PG8_LDB(B1, 0, 1); PG8_SCHED; PG8_LDA(At, 0, 0); PG8_STAGE(PG8_SA(1, 1), a1 + hstep, voffA);
            PG8_WAIT_V(8); PG8_WAIT_L(0); PG8_BAR; PG8_MMA(0, 0, At, B0); PG8_MMA(0, 1, At, B1); PG8_BAR; PG8_SCHED;
            PG8_LDA(At, 0, 1); PG8_STAGE(PG8_SB(0, 0), b2, voffA); PG8_STAGE(PG8_SB(0, 1), b2 + hstep, voffA); PG8_STAGE(PG8_SA(0, 0), a2, voffA);
            PG8_WAIT_V(8); PG8_WAIT_L(0); PG8_BAR; PG8_MMA(1, 0, At, B0); PG8_MMA(1, 1, At, B1); PG8_BAR; PG8_SCHED;
            PG8_LDB(B0, 1, 0); PG8_LDB(B1, 1, 1); PG8_SCHED; PG8_LDA(At, 1, 0); PG8_STAGE(PG8_SA(0, 1), a2 + hstep, voffA);
            PG8_WAIT_V(8); PG8_WAIT_L(0); PG8_BAR; PG8_MMA(0, 0, At, B0); PG8_MMA(0, 1, At, B1); PG8_BAR; PG8_SCHED;
            PG8_LDA(At, 1, 1); PG8_STAGE(PG8_SB(1, 0), b3, voffA); PG8_STAGE(PG8_SB(1, 1), b3 + hstep, voffA); PG8_STAGE(PG8_SA(1, 0), a3, voffA);
            PG8_WAIT_V(8); PG8_WAIT_L(0); PG8_BAR; PG8_MMA(1, 0, At, B0); PG8_MMA(1, 1, At, B1); PG8_BAR; PG8_SCHED;
        }
        if constexpr (ALIGN_EPI) { if (wr == 0) PG8_BAR; }
        E(acc, cur, wr, wc, fr, fq);
        if (!has_next) break;
#pragma unroll
        for (int a = 0; a < 2; ++a)
#pragma unroll
            for (int b = 0; b < 2; ++b)
#pragma unroll
                for (int m = 0; m < 4; ++m)
#pragma unroll
                    for (int n = 0; n < 2; ++n) acc[a][b][m][n] = (f32x4){0.f, 0.f, 0.f, 0.f};
        cur = nxt; cA = nA; cB = nB; ++ui;
        if constexpr (ALIGN_EPI) { if (wr == 1) PG8_BAR; }
    }
    PG8_WAIT_V(0);
    if constexpr (!ALIGN_EPI) { if (wr == 0) PG8_BAR; }
    PG8_BAR;
#undef PG8_SA
#undef PG8_SB
#undef PG8_STAGE
#undef PG8_LDA
#undef PG8_LDB
#undef PG8_MMA
#undef PG8_WAIT_V
#undef PG8_WAIT_L
#undef PG8_BAR
#undef PG8_SCHED
}
}

typedef f32x4 Acc[2][2][4][2];
struct EpiA {
    unsigned char* ws; const float* cs;
    DI void operator()(const Acc& acc, const pg8::Unit& u, int wr, int wc, int fr, int fq) const {
        const int pn = u.pn; size_t off; int ld, colb, rot; float sc;
        if (pn < 2) { off = OFF_RQ; ld = 512; colb = pn * 256; rot = 1; sc = 1.f; }
        else if (pn < 4) { off = OFF_RK; ld = 512; colb = (pn - 2) * 256; rot = 1; sc = 0.08838834764831845f; }
        else if (pn < 8) { off = OFF_RV; ld = 1024; colb = (pn - 4) * 256; rot = 0; sc = 1.f; }
        else if (pn < 12) { off = OFF_AQ; ld = 1024; colb = (pn - 8) * 256; rot = 1; sc = 0.08838834764831845f * LOG2E; }
        else if (pn == 12) { off = OFF_AK; ld = 256; colb = 0; rot = 1; sc = 1.f; }
        else { off = OFF_AV; ld = 256; colb = 0; rot = 0; sc = 1.f; }
        bf16_t* dst = (bf16_t*)(ws + off);
#pragma unroll
        for (int ai = 0; ai < 2; ++ai)
#pragma unroll
            for (int m = 0; m < 4; ++m) {
                const int r = u.pm * 256 + ai * 128 + wr * 64 + m * 16 + fr;
                const int p = r >= LP ? r - LP : r; const int t = p >= MPAD ? p - MPAD : 0;
                f32x4 c4 = (f32x4){sc, sc, sc, sc}, s4 = (f32x4){0.f, 0.f, 0.f, 0.f};
                if (rot) { const f32x4* pc = (const f32x4*)(cs + ((size_t)t * 64 + 16 * wc + 4 * fq) * 2); const f32x4 x0 = pc[0], x1 = pc[1];
                    c4 = (f32x4){x0[0], x0[2], x1[0], x1[2]} * sc; s4 = (f32x4){x0[1], x0[3], x1[1], x1[3]} * sc; }
                bf16_t* rowp = dst + (size_t)r * ld + colb + 16 * wc + 4 * fq;
#pragma unroll
                for (int bj = 0; bj < 2; ++bj) {
                    const f32x4 v0 = acc[ai][bj][m][0], v1 = acc[ai][bj][m][1];
                    const f32x4 o0 = v0 * c4 - v1 * s4, o1 = v1 * c4 + v0 * s4;
                    u32x2 w0, w1; w0.x = cvt_pk_bf16(o0[0], o0[1]); w0.y = cvt_pk_bf16(o0[2], o0[3]); w1.x = cvt_pk_bf16(o1[0], o1[1]); w1.y = cvt_pk_bf16(o1[2], o1[3]);
                    *(u32x2*)(rowp + bj * 128) = w0; *(u32x2*)(rowp + bj * 128 + 64) = w1;
                }
            }
    }
};
DI float sigmoidf_(float x) { return __builtin_amdgcn_rcpf(1.f + __expf(-x)); }
struct EpiGate {
    unsigned char* ws;
    DI void operator()(const Acc& acc, const pg8::Unit& u, int wr, int wc, int fr, int fq) const {
        const int seg = u.pn >> 2, colb = (u.pn & 3) * 256;
        bf16_t* dst = (bf16_t*)(ws + (seg == 0 ? OFF_OR : seg == 1 ? OFF_OA : seg == 2 ? OFF_SGR : OFF_SGA));
#pragma unroll
        for (int ai = 0; ai < 2; ++ai)
#pragma unroll
            for (int m = 0; m < 4; ++m) {
                const int r = u.pm * 256 + ai * 128 + wr * 64 + m * 16 + fr;
#pragma unroll
                for (int bj = 0; bj < 2; ++bj)
#pragma unroll
                    for (int n = 0; n < 2; ++n) {
                        bf16_t* p = dst + (size_t)r * 1024 + colb + bj * 128 + wc * 32 + n * 16 + 4 * fq;
                        const f32x4 a = acc[ai][bj][m][n]; f32x4 o;
#pragma unroll
                        for (int e = 0; e < 4; ++e) o[e] = sigmoidf_(a[e]);
                        if (seg < 2) { const u32x2 w = *(const u32x2*)p; o = o * a; o[0] *= bflo(w.x); o[1] *= bfhi(w.x); o[2] *= bflo(w.y); o[3] *= bfhi(w.y); }
                        u32x2 w2; w2.x = cvt_pk_bf16(o[0], o[1]); w2.y = cvt_pk_bf16(o[2], o[3]); *(u32x2*)p = w2;
                    }
            }
    }
};
template <int MODE> struct EpiPost {
    unsigned char* ws;
    DI void operator()(const Acc& acc, const pg8::Unit& u, int wr, int wc, int fr, int fq) const {
#pragma unroll
        for (int ai = 0; ai < 2; ++ai)
#pragma unroll
            for (int m = 0; m < 4; ++m) {
                const int r = u.pm * 256 + ai * 128 + wr * 64 + m * 16 + fr;
#pragma unroll
                for (int bj = 0; bj < 2; ++bj)
#pragma unroll
                    for (int n = 0; n < 2; ++n) {
                        const size_t idx = (size_t)r * 1024 + u.pn * 256 + bj * 128 + wc * 32 + n * 16 + 4 * fq;
                        const f32x4 a = acc[ai][bj][m][n];
                        if (MODE == 2) { *(f32x4*)((float*)(ws + OFF_OUT) + idx) = a; }
                        else {
                            const u32x2 w = *(const u32x2*)((const bf16_t*)(ws + (MODE == 0 ? OFF_SGR : OFF_SGA)) + idx);
                            f32x4 o = (f32x4){a[0] * bflo(w.x), a[1] * bfhi(w.x), a[2] * bflo(w.y), a[3] * bfhi(w.y)};
                            if (MODE == 0) { *(f32x4*)((float*)(ws + OFF_PART) + idx) = o; }
                            else { o = o + *(const f32x4*)((const float*)(ws + OFF_PART) + idx);
                                u32x2 w2; w2.x = cvt_pk_bf16(o[0], o[1]); w2.y = cvt_pk_bf16(o[2], o[3]); *(u32x2*)((bf16_t*)(ws + OFF_MIX) + idx) = w2; }
                        }
                    }
            }
    }
};

struct Args {
    const float* x; const float* meta; const float* pre_w; const float* w_in; const float* dec_f; const float* dec_b; const float* ret_nw;
    const float* w_rb; const float* sink; const float* w_ab; const float* w_o; const float* post_w;
    float* out; unsigned char* ws; int ph_lo, ph_hi;
};

DI int win_dst_row(int c) {
    int d;
    if (c < 2048) d = c; else if (c < 3072) d = 3584 + (c - 2048); else if (c < 4608) d = 2048 + (c - 3072); else d = c;
    if (d < NA) { const int q = d & 127; d = (d & ~127) + 32 * ((q >> 4) & 3) + 16 * (q >> 6) + (q & 15); }
    return d;
}
template <bool WIN>
DI void p0_transpose_item(const float* W, int K, int N, bf16_t* WT, LAS float* scr, int item, int lane) {
    const int nblk = N / 32, kb = item / nblk, nb = item % nblk, k0 = 64 * kb, n0 = 32 * nb;
#pragma unroll 8
    for (int i = 0; i < 32; ++i) { const int kk = 2 * i + (lane >> 5); scr[kk * 33 + (lane & 31)] = W[(size_t)(k0 + kk) * N + n0 + (lane & 31)]; }
    LDS_WAIT();
    const int c = lane & 7;
#pragma unroll
    for (int j = 0; j < 4; ++j) { const int n = (lane >> 3) + 8 * j; const LAS float* s = scr + (8 * c) * 33 + n;
        u32x4 o; o.x = cvt_pk_bf16(s[0 * 33], s[1 * 33]); o.y = cvt_pk_bf16(s[2 * 33], s[3 * 33]); o.z = cvt_pk_bf16(s[4 * 33], s[5 * 33]); o.w = cvt_pk_bf16(s[6 * 33], s[7 * 33]);
        const int drow = WIN ? win_dst_row(n0 + n) : (n0 + n);
        *(u32x4*)(WT + (size_t)drow * K + k0 + 8 * c) = o; }
    LDS_WAIT();
}
DI void phase_prologue(LAS unsigned char* lds, const Args& A) {
    const int tid = threadIdx.x, lane = tid & 63, wave = tid >> 6;
    const int gw = blockIdx.x * 8 + wave, NGW = gridDim.x * 8;
    unsigned char* dob = (unsigned char*)A.out;
    LAS float* scr = (LAS float*)(lds + wave * 16384);
    constexpr int I_IN = (DM / 64) * (DIN / 32), I_SQ = (DM / 64) * (DM / 32);
    for (int it = gw; it < I_IN + 3 * I_SQ; it += NGW) {
        int r = it;
        if (r < I_IN) { p0_transpose_item<true>(A.w_in, DM, DIN, (bf16_t*)(dob + DO_WIN), scr, r, lane); continue; } r -= I_IN;
        if (r < I_SQ) { p0_transpose_item<false>(A.w_rb, DM, DM, (bf16_t*)(dob + DO_WRB), scr, r, lane); continue; } r -= I_SQ;
        if (r < I_SQ) { p0_transpose_item<false>(A.w_ab, DM, DM, (bf16_t*)(dob + DO_WAB), scr, r, lane); continue; } r -= I_SQ;
        p0_transpose_item<false>(A.w_o, DM, DM, (bf16_t*)(dob + DO_WO), scr, r, lane);
    }
    bf16_t* U = (bf16_t*)(dob + DO_U);
    for (int r = gw; r < MP; r += NGW) {
        const int b = r >= LP ? 1 : 0, p = r - b * LP;
        u32x2* o8 = (u32x2*)(U + (size_t)r * DM) + lane;
        if (p < MPAD) {
#pragma unroll
            for (int j = 0; j < 4; ++j) o8[64 * j] = (u32x2){0u, 0u};
            continue; }
        const int t = p - MPAD;
        const float* src = t < NMETA ? A.meta + (size_t)t * DM : A.x + ((size_t)b * SEQ + (t - NMETA)) * DM;
        const f32x4* xr = (const f32x4*)src + lane; const f32x4* wr4 = (const f32x4*)A.pre_w + lane;
        f32x4 v[4]; float s = 0.f;
#pragma unroll
        for (int j = 0; j < 4; ++j) { v[j] = xr[64 * j]; s += (v[j][0] * v[j][0] + v[j][1] * v[j][1]) + (v[j][2] * v[j][2] + v[j][3] * v[j][3]); }
        const float rs = rsqrtf(wave_sum(s) * (1.f / DM) + EPSF);
#pragma unroll
        for (int j = 0; j < 4; ++j) { const f32x4 w = wr4[64 * j]; const f32x4 y = v[j] * rs * w; o8[64 * j] = (u32x2){cvt_pk_bf16(y[0], y[1]), cvt_pk_bf16(y[2], y[3])}; }
    }
    float* cs = (float*)(dob + DO_CS);
    for (int i = blockIdx.x * 512 + tid; i < TT * 64; i += gridDim.x * 512) {
        const int t = i >> 6, f = i & 63;
        const float inv = (float)exp2(-(double)f * (2.0 / 128.0) * 13.287712379549449);
        const float ang = (float)t * inv;
        double rev = (double)ang * 0.15915494309189535; rev -= floor(rev);
        const float fr = (float)rev;
        cs[2 * i] = __builtin_amdgcn_cosf(fr); cs[2 * i + 1] = __builtin_amdgcn_sinf(fr);
    }
}

template <int ROWS> DI void stage_plain(LAS bf16_t* dst, const bf16_t* src, int ld, int tid) {
#pragma unroll
    for (int i = 0; i < ROWS / 32; ++i) { const int id = tid + 512 * i, row = id >> 4, c8 = id & 15;
        const u32x4 v = *(const u32x4*)(src + (size_t)row * ld + c8 * 8); *(LAS u32x4*)(dst + row * LDT + c8 * 8) = v; }
}
template <int NCOLS> DI void stage_transposed(LAS bf16_t* dst, const bf16_t* src, int ld, int tid) {
    const int j = tid & 127;
#pragma unroll
    for (int i = 0; i < NCOLS / 32; ++i) { const int g8 = (tid >> 7) + 4 * i;
        const u32x4 v = *(const u32x4*)(src + (size_t)j * ld + g8 * 8);
        LAS bf16_t* d = dst + (g8 * 8) * LDT + j;
        d[0 * LDT] = (bf16_t)(v.x & 0xffff); d[1 * LDT] = (bf16_t)(v.x >> 16); d[2 * LDT] = (bf16_t)(v.y & 0xffff); d[3 * LDT] = (bf16_t)(v.y >> 16);
        d[4 * LDT] = (bf16_t)(v.z & 0xffff); d[5 * LDT] = (bf16_t)(v.z >> 16); d[6 * LDT] = (bf16_t)(v.w & 0xffff); d[7 * LDT] = (bf16_t)(v.w >> 16); }
}
DI bf16x8 scale_frag(bf16x8 a, float s) {
    const u32x4 w = __builtin_bit_cast(u32x4, a); u32x4 o;
    o.x = cvt_pk_bf16(bflo(w.x) * s, bfhi(w.x) * s); o.y = cvt_pk_bf16(bflo(w.y) * s, bfhi(w.y) * s);
    o.z = cvt_pk_bf16(bflo(w.z) * s, bfhi(w.z) * s); o.w = cvt_pk_bf16(bflo(w.w) * s, bfhi(w.w) * s);
    return __builtin_bit_cast(bf16x8, o);
}
DI float log2_sigmoid(float d) { return -log2f(1.f + expf(-d)); }
DI size_t kvs_off(int dir, int b, int n, int h) { return ((((size_t)dir * NB + b) * NCH + n) * RH + h) * 32768; }

DI void ret_kv_unit(LAS unsigned char* lds, const Args& A, int b, int n, int h) {
    const int tid = threadIdx.x, lane = tid & 63, w = tid >> 6, fr = lane & 15, fq = lane >> 4;
    LAS bf16_t* Vt = (LAS bf16_t*)lds;
    LAS bf16_t* Kf = Vt + 256 * LDT;
    LAS bf16_t* Kb = Kf + 128 * LDT;
    const float lgf = log2_sigmoid(A.dec_f[h]), lgb = log2_sigmoid(A.dec_b[h]);
    const size_t row0 = (size_t)b * LP + (size_t)n * CH;
    const bf16_t* RK = (const bf16_t*)(A.ws + OFF_RK) + row0 * 512 + h * 128;
    const bf16_t* RV = (const bf16_t*)(A.ws + OFF_RV) + row0 * 1024 + h * 256;
    stage_transposed<256>(Vt, RV, 1024, tid);
    {
        const int j = tid & 127; const float wf = exp2f((float)(127 - j) * lgf), wb = exp2f((float)j * lgb);
#pragma unroll
        for (int i = 0; i < 4; ++i) { const int g8 = (tid >> 7) + 4 * i;
            const u32x4 v = *(const u32x4*)(RK + (size_t)j * 512 + g8 * 8);
            float f[8] = {bflo(v.x), bfhi(v.x), bflo(v.y), bfhi(v.y), bflo(v.z), bfhi(v.z), bflo(v.w), bfhi(v.w)};
#pragma unroll
            for (int e = 0; e < 8; ++e) { Kf[(g8 * 8 + e) * LDT + j] = (bf16_t)(cvt_pk_bf16(f[e] * wf, 0.f) & 0xffff); Kb[(g8 * 8 + e) * LDT + j] = (bf16_t)(cvt_pk_bf16(f[e] * wb, 0.f) & 0xffff); } }
    }
    __syncthreads();
#pragma unroll 1
    for (int dir = 0; dir < 2; ++dir) {
        const LAS bf16_t* Kx = dir ? Kb : Kf;
        f32x4 aF[2][8];
#pragma unroll
        for (int mt = 0; mt < 2; ++mt)
#pragma unroll
            for (int nt = 0; nt < 8; ++nt) aF[mt][nt] = (f32x4){0.f, 0.f, 0.f, 0.f};
#pragma unroll
        for (int ks = 0; ks < 4; ++ks) {
            bf16x8 a[2];
#pragma unroll
            for (int mt = 0; mt < 2; ++mt) a[mt] = *(const LAS bf16x8*)(Vt + (32 * w + 16 * mt + fr) * LDT + ks * 32 + fq * 8);
#pragma unroll
            for (int nt = 0; nt < 8; ++nt) {
                const bf16x8 bf = *(const LAS bf16x8*)(Kx + (16 * nt + fr) * LDT + ks * 32 + fq * 8);
#pragma unroll
                for (int mt = 0; mt < 2; ++mt) aF[mt][nt] = mfma16(bf, a[mt], aF[mt][nt]);
            }
        }
        bf16_t* of = (bf16_t*)(A.ws + OFF_KVS) + kvs_off(dir, b, n, h);
#pragma unroll
        for (int mt = 0; mt < 2; ++mt)
#pragma unroll
            for (int nt = 0; nt < 8; ++nt) { const int o = (32 * w + 16 * mt + fr) * 128 + 16 * nt + 4 * fq;
                *(u32x2*)(of + o) = (u32x2){cvt_pk_bf16(aF[mt][nt][0], aF[mt][nt][1]), cvt_pk_bf16(aF[mt][nt][2], aF[mt][nt][3])}; }
    }
    __syncthreads();
}

DI void phase_scan(const Args& A) {
    bf16_t* KVS = (bf16_t*)(A.ws + OFF_KVS);
    for (int idx = blockIdx.x * 512 + threadIdx.x; idx < 2 * NB * RH * 8192; idx += gridDim.x * 512) {
        const int e4 = idx & 8191, h = (idx >> 13) & 3, b = (idx >> 15) & 1, dir = idx >> 16;
        const float lg = log2_sigmoid(dir ? A.dec_b[h] : A.dec_f[h]); const float cd = exp2f(128.f * lg);
        f32x4 S = (f32x4){0.f, 0.f, 0.f, 0.f};
#pragma unroll 1
        for (int g = 0; g < 5; ++g) {
            u32x2 v[13];
#pragma unroll
            for (int k = 0; k < 13; ++k) { const int s = g * 13 + k, n = dir ? (NCH - 1 - s) : s; v[k] = *(const u32x2*)(KVS + kvs_off(dir, b, n, h) + (size_t)e4 * 4); }
#pragma unroll
            for (int k = 0; k < 13; ++k) { const int s = g * 13 + k, n = dir ? (NCH - 1 - s) : s;
                *(u32x2*)(KVS + kvs_off(dir, b, n, h) + (size_t)e4 * 4) = (u32x2){cvt_pk_bf16(S[0], S[1]), cvt_pk_bf16(S[2], S[3])};
                S = S * cd + (f32x4){bflo(v[k].x), bfhi(v[k].x), bflo(v[k].y), bfhi(v[k].y)}; }
        }
    }
}

DI void ret_out_unit(LAS unsigned char* lds, const Args& A, int b, int n, int h) {
    const int tid = threadIdx.x, lane = tid & 63, w = tid >> 6, fr = lane & 15, fq = lane >> 4;
    LAS bf16_t* Kt = (LAS bf16_t*)lds;
    LAS bf16_t* Vt = Kt + 128 * LDT;
    LAS bf16_t* Pw = Vt + 256 * LDT + w * 16 * LDT;
    const float lgf = log2_sigmoid(A.dec_f[h]), lgb = log2_sigmoid(A.dec_b[h]);
    const size_t row0 = (size_t)b * LP + (size_t)n * CH;
    const int i = 16 * w + fr;
    bf16x8 q[4];
    { const bf16_t* qp = (const bf16_t*)(A.ws + OFF_RQ) + (row0 + i) * 512 + h * 128 + fq * 8;
#pragma unroll
      for (int ks = 0; ks < 4; ++ks) q[ks] = *(const bf16x8*)(qp + ks * 32); }
    stage_plain<128>(Kt, (const bf16_t*)(A.ws + OFF_RK) + row0 * 512 + h * 128, 512, tid);
    stage_transposed<256>(Vt, (const bf16_t*)(A.ws + OFF_RV) + row0 * 1024 + h * 256, 1024, tid);
    __syncthreads();
    f32x4 S[8];
#pragma unroll
    for (int nt = 0; nt < 8; ++nt) S[nt] = (f32x4){0.f, 0.f, 0.f, 0.f};
#pragma unroll
    for (int ks = 0; ks < 4; ++ks)
#pragma unroll
        for (int nt = 0; nt < 8; ++nt) S[nt] = mfma16(*(const LAS bf16x8*)(Kt + (16 * nt + fr) * LDT + ks * 32 + fq * 8), q[ks], S[nt]);
#pragma unroll
    for (int nt = 0; nt < 8; ++nt) {
#pragma unroll
        for (int e = 0; e < 4; ++e) { const int d = i - (16 * nt + 4 * fq + e); S[nt][e] *= d >= 0 ? exp2f((float)d * lgf) : exp2f((float)(-d) * lgb); }
        *(LAS u32x2*)(Pw + fr * LDT + 16 * nt + 4 * fq) = (u32x2){cvt_pk_bf16(S[nt][0], S[nt][1]), cvt_pk_bf16(S[nt][2], S[nt][3])};
    }
    LDS_WAIT();
    f32x4 O[16];
#pragma unroll
    for (int nt = 0; nt < 16; ++nt) O[nt] = (f32x4){0.f, 0.f, 0.f, 0.f};
#pragma unroll
    for (int ks = 0; ks < 4; ++ks) { const bf16x8 p = *(const LAS bf16x8*)(Pw + fr * LDT + ks * 32 + fq * 8);
#pragma unroll
        for (int nt = 0; nt < 16; ++nt) O[nt] = mfma16(*(const LAS bf16x8*)(Vt + (16 * nt + fr) * LDT + ks * 32 + fq * 8), p, O[nt]); }
#pragma unroll
    for (int dir = 0; dir < 2; ++dir) {
        __syncthreads();
        stage_plain<256>(Vt, (const bf16_t*)(A.ws + OFF_KVS) + kvs_off(dir, b, n, h), 128, tid);
        __syncthreads();
        const float qs = dir ? exp2f((float)(128 - i) * lgb) : exp2f((float)(i + 1) * lgf);
#pragma unroll
        for (int ks = 0; ks < 4; ++ks) { const bf16x8 p = scale_frag(q[ks], qs);
#pragma unroll
            for (int nt = 0; nt < 16; ++nt) O[nt] = mfma16(*(const LAS bf16x8*)(Vt + (16 * nt + fr) * LDT + ks * 32 + fq * 8), p, O[nt]); }
    }
    float s = 0.f;
#pragma unroll
    for (int nt = 0; nt < 16; ++nt) s += (O[nt][0] + O[nt][1]) + (O[nt][2] + O[nt][3]);
    s += __shfl_xor(s, 16); s += __shfl_xor(s, 32);
    const float mu = s * (1.f / 256.f); float q2 = 0.f;
#pragma unroll
    for (int nt = 0; nt < 16; ++nt) { const f32x4 d = O[nt] - mu; q2 += (d[0] * d[0] + d[1] * d[1]) + (d[2] * d[2] + d[3] * d[3]); }
    q2 += __shfl_xor(q2, 16); q2 += __shfl_xor(q2, 32);
    const float rstd = rsqrtf(q2 * (1.f / 256.f) + EPSF);
    bf16_t* orow = (bf16_t*)(A.ws + OFF_OR) + ((size_t)b * SEQ + (size_t)(n - 1) * CH + i) * 1024 + h * 256;
    const float* nw = A.ret_nw + h * 256;
#pragma unroll
    for (int nt = 0; nt < 16; ++nt) { const f32x4 wv = *(const f32x4*)(nw + 16 * nt + 4 * fq); const f32x4 y = (O[nt] - mu) * rstd * wv;
        *(u32x2*)(orow + 16 * nt + 4 * fq) = (u32x2){cvt_pk_bf16(y[0], y[1]), cvt_pk_bf16(y[2], y[3])}; }
    __syncthreads();
}

DI void attn_unit(LAS unsigned char* lds, const Args& A, int b, int g, int n, int half) {
    const int tid = threadIdx.x, lane = tid & 63, w = tid >> 6, fr = lane & 15, fq = lane >> 4;
    LAS bf16_t* Kt = (LAS bf16_t*)lds;
    LAS bf16_t* Vt = Kt + 128 * LDT;
    LAS bf16_t* Pw = Vt + 128 * LDT + w * 16 * LDT;
    const int head = g * 4 + (w >> 1), rbase = 64 * half + 32 * (w & 1);
    const float NEG = -1e30f;
    const float sinkl = A.sink[head] * LOG2E;
    f32x4 O[2][8]; float mrun[2], lrun[2];
#pragma unroll
    for (int mt = 0; mt < 2; ++mt) { mrun[mt] = sinkl; lrun[mt] = 1.f;
#pragma unroll
        for (int nt = 0; nt < 8; ++nt) O[mt][nt] = (f32x4){0.f, 0.f, 0.f, 0.f}; }
    const size_t qrow0 = (size_t)b * LP + (size_t)n * CH;
    const bf16_t* AQ = (const bf16_t*)(A.ws + OFF_AQ) + qrow0 * 1024 + head * 128 + fq * 8;
#pragma unroll 1
    for (int kt = 0; kt < 4; ++kt) {
        const int kc = kt == 3 ? 0 : n - 1 + kt;
        if ((kt == 0 && n < 2) || (kt == 2 && n > NCH - 2)) continue;
        const size_t krow0 = (size_t)b * LP + (size_t)kc * CH;
        __syncthreads();
        stage_plain<128>(Kt, (const bf16_t*)(A.ws + OFF_AK) + krow0 * 256 + g * 128, 256, tid);
        stage_transposed<128>(Vt, (const bf16_t*)(A.ws + OFF_AV) + krow0 * 256 + g * 128, 256, tid);
        __syncthreads();
#pragma unroll
        for (int mt = 0; mt < 2; ++mt) {
            const int ii = rbase + 16 * mt + fr;
            bf16x8 q[4];
#pragma unroll
            for (int ks = 0; ks < 4; ++ks) q[ks] = *(const bf16x8*)(AQ + (size_t)ii * 1024 + ks * 32);
            f32x4 S[8];
#pragma unroll
            for (int nt = 0; nt < 8; ++nt) S[nt] = (f32x4){0.f, 0.f, 0.f, 0.f};
#pragma unroll
            for (int ks = 0; ks < 4; ++ks)
#pragma unroll
                for (int nt = 0; nt < 8; ++nt) S[nt] = mfma16(*(const LAS bf16x8*)(Kt + (16 * nt + fr) * LDT + ks * 32 + fq * 8), q[ks], S[nt]);
            float mx = NEG;
#pragma unroll
            for (int nt = 0; nt < 8; ++nt)
#pragma unroll
                for (int e = 0; e < 4; ++e) { const int jj = 16 * nt + 4 * fq + e;
                    const bool ok = kt == 0 ? (jj >= ii) : kt == 1 ? true : kt == 2 ? (jj <= ii) : (jj >= MPAD);
                    S[nt][e] = ok ? S[nt][e] : NEG; mx = fmaxf(mx, S[nt][e]); }
            mx = fmaxf(mx, __shfl_xor(mx, 16)); mx = fmaxf(mx, __shfl_xor(mx, 32));
            const float mnew = fmaxf(mrun[mt], mx), alpha = exp2f(mrun[mt] - mnew);
            float rs = 0.f;
#pragma unroll
            for (int nt = 0; nt < 8; ++nt) {
#pragma unroll
                for (int e = 0; e < 4; ++e) { S[nt][e] = exp2f(S[nt][e] - mnew); rs += S[nt][e]; }
                *(LAS u32x2*)(Pw + fr * LDT + 16 * nt + 4 * fq) = (u32x2){cvt_pk_bf16(S[nt][0], S[nt][1]), cvt_pk_bf16(S[nt][2], S[nt][3])};
            }
            rs += __shfl_xor(rs, 16); rs += __shfl_xor(rs, 32);
            lrun[mt] = lrun[mt] * alpha + rs; mrun[mt] = mnew;
#pragma unroll
            for (int nt = 0; nt < 8; ++nt) O[mt][nt] = O[mt][nt] * alpha;
            LDS_WAIT();
#pragma unroll
            for (int ks = 0; ks < 4; ++ks) { const bf16x8 p = *(const LAS bf16x8*)(Pw + fr * LDT + ks * 32 + fq * 8);
#pragma unroll
                for (int nt = 0; nt < 8; ++nt) O[mt][nt] = mfma16(*(const LAS bf16x8*)(Vt + (16 * nt + fr) * LDT + ks * 32 + fq * 8), p, O[mt][nt]); }
            LDS_WAIT();
        }
    }
    bf16_t* OA = (bf16_t*)(A.ws + OFF_OA) + ((size_t)b * SEQ + (size_t)(n - 1) * CH) * 1024 + head * 128;
#pragma unroll
    for (int mt = 0; mt < 2; ++mt) { const float inv = 1.f / lrun[mt]; const int ii = rbase + 16 * mt + fr;
#pragma unroll
        for (int nt = 0; nt < 8; ++nt) { const f32x4 y = O[mt][nt] * inv;
            *(u32x2*)(OA + (size_t)ii * 1024 + 16 * nt + 4 * fq) = (u32x2){cvt_pk_bf16(y[0], y[1]), cvt_pk_bf16(y[2], y[3])}; } }
    __syncthreads();
}

DI void phase_final(const Args& A) {
    const int tid = threadIdx.x, lane = tid & 63, wave = tid >> 6;
    const float* OUT = (const float*)(A.ws + OFF_OUT);
    for (int r = blockIdx.x * 8 + wave; r < MS; r += gridDim.x * 8) {
        const f32x4* o4 = (const f32x4*)(OUT + (size_t)r * DM) + lane; const f32x4* x4 = (const f32x4*)(A.x + (size_t)r * DM) + lane;
        const f32x4* w4 = (const f32x4*)A.post_w + lane; f32x4* d4 = (f32x4*)(A.out + (size_t)r * DM) + lane;
        f32x4 v[4]; float s = 0.f;
#pragma unroll
        for (int j = 0; j < 4; ++j) { v[j] = o4[64 * j]; s += (v[j][0] * v[j][0] + v[j][1] * v[j][1]) + (v[j][2] * v[j][2] + v[j][3] * v[j][3]); }
        const float rs = rsqrtf(wave_sum(s) * (1.f / DM) + EPSF);
#pragma unroll
        for (int j = 0; j < 4; ++j) d4[64 * j] = x4[64 * j] + v[j] * rs * w4[64 * j];
    }
}

constexpr int NPHASE = 10;
__global__ void __launch_bounds__(512, 2) fwd_kernel(Args A) {
    extern __shared__ __attribute__((aligned(16))) unsigned char lds_raw[];
    LAS unsigned char* lds = (LAS unsigned char*)lds_raw;
    const int lo = A.ph_lo, hi = A.ph_hi, G = gridDim.x, bx = blockIdx.x;
    unsigned char* dob = (unsigned char*)A.out;
#ifndef PH_MASK
#define PH_MASK 0x3ff
#endif
#define IN(k) (((PH_MASK >> (k)) & 1) && lo <= (k) && (k) < hi)
#define SEAM(k) do { if (IN(k) && IN((k) + 1)) cg::this_grid().sync(); } while (0)
    if (IN(0)) { phase_prologue(lds, A); __syncthreads(); }
    SEAM(0);
    if (IN(1)) {
        pg8::Gemm g{(const bf16_t*)(dob + DO_U), (const bf16_t*)(dob + DO_WIN), MP, NA, DM, 0}; pg8::StaticOrder S; S.init(MP, NA, G, bx);
        EpiA E{A.ws, (const float*)(dob + DO_CS)};
        pg8::gemm_phase<EpiA, true>(lds, g, S, E);
    }
    SEAM(1);
    if (IN(2)) {
        for (int u = bx; u < 2 * NB * AG * (NCH - 1); u += G) { const int half = u & 1, v = u >> 1, n = 1 + v % (NCH - 1), bg = v / (NCH - 1); attn_unit(lds, A, bg >> 1, bg & 1, n, half); }
        for (int u = bx; u < NB * NCH * RH; u += G) { const int h = u & 3, bn = u >> 2; ret_kv_unit(lds, A, bn / NCH, bn % NCH, h); }
    }
    SEAM(2);
    if (IN(3)) phase_scan(A);
    SEAM(3);
    if (IN(4)) {
        for (int u = bx; u < NB * (NCH - 1) * RH; u += G) { const int h = u & 3, bn = u >> 2; ret_out_unit(lds, A, bn / (NCH - 1), 1 + bn % (NCH - 1), h); }
    }
    SEAM(4);
    if (IN(5)) {
        pg8::Gemm g{(const bf16_t*)(dob + DO_U), (const bf16_t*)(dob + DO_WIN) + (size_t)NA * DM, MS, NGATE, DM, 1}; pg8::StaticOrder S; S.init(MS, NGATE, G, bx);
        EpiGate E{A.ws};
        pg8::gemm_phase<EpiGate, true>(lds, g, S, E);
    }
    SEAM(5);
    if (IN(6)) {
        pg8::Gemm g{(const bf16_t*)(A.ws + OFF_OR), (const bf16_t*)(dob + DO_WRB), MS, DM, DM, 0}; pg8::StaticOrder S; S.init(MS, DM, G, bx);
        EpiPost<0> E{A.ws};
        pg8::gemm_phase<EpiPost<0>, false>(lds, g, S, E);
    }
    if (IN(6) && IN(7)) __syncthreads();
    if (IN(7)) {
        pg8::Gemm g{(const bf16_t*)(A.ws + OFF_OA), (const bf16_t*)(dob + DO_WAB), MS, DM, DM, 0}; pg8::StaticOrder S; S.init(MS, DM, G, bx);
        EpiPost<1> E{A.ws};
        pg8::gemm_phase<EpiPost<1>, false>(lds, g, S, E);
    }
    SEAM(7);
    if (IN(8)) {
        pg8::Gemm g{(const bf16_t*)(A.ws + OFF_MIX), (const bf16_t*)(dob + DO_WO), MS, DM, DM, 0}; pg8::StaticOrder S; S.init(MS, DM, G, bx);
        EpiPost<2> E{A.ws};
        pg8::gemm_phase<EpiPost<2>, false>(lds, g, S, E);
    }
    SEAM(8);
    if (IN(9)) phase_final(A);
#undef IN
#undef SEAM
}

extern "C" void kernel_launch(void* const* d_in, const int* in_sizes, int n_in, void* d_out, int out_size, void* d_ws, size_t ws_size, hipStream_t stream) {
    static int grid = 0;
    if (grid == 0) {
        if (n_in != 12 || out_size != MS * DM || ws_size < WS_END) { fprintf(stderr, "kernel_launch: unexpected shapes (n_in %d out %d ws %zu)\n", n_in, out_size, ws_size); grid = -1; return; }
        int dev = 0, cus = 0, per_cu = 0;
        hipGetDevice(&dev); hipDeviceGetAttribute(&cus, hipDeviceAttributeMultiprocessorCount, dev);
        if (hipFuncSetAttribute((const void*)fwd_kernel, hipFuncAttributeMaxDynamicSharedMemorySize, LDS_BYTES) != hipSuccess) { fprintf(stderr, "kernel_launch: hipFuncSetAttribute failed\n"); grid = -1; return; }
        hipOccupancyMaxActiveBlocksPerMultiprocessor(&per_cu, (const void*)fwd_kernel, 512, LDS_BYTES);
        (void)hipGetLastError();
        if (per_cu < 1) { fprintf(stderr, "kernel_launch: occupancy query says %d blocks per CU\n", per_cu); per_cu = 1; }
        grid = cus;
    }
    if (grid < 0) return;
    Args a{};
    a.x = (const float*)d_in[0]; a.meta = (const float*)d_in[1]; a.pre_w = (const float*)d_in[2]; a.w_in = (const float*)d_in[3];
    a.dec_f = (const float*)d_in[4]; a.dec_b = (const float*)d_in[5]; a.ret_nw = (const float*)d_in[6]; a.w_rb = (const float*)d_in[7];
    a.sink = (const float*)d_in[8]; a.w_ab = (const float*)d_in[9]; a.w_o = (const float*)d_in[10]; a.post_w = (const float*)d_in[11];
    a.out = (float*)d_out; a.ws = (unsigned char*)d_ws;
#if MK_N_LAUNCHES == 1
    a.ph_lo = 0; a.ph_hi = NPHASE;
    void* args[] = {&a};
    hipError_t e = hipLaunchCooperativeKernel((const void*)fwd_kernel, dim3(grid), dim3(512), args, LDS_BYTES, stream);
    if (e != hipSuccess) fprintf(stderr, "cooperative launch failed: %s (grid %d)\n", hipGetErrorString(e), grid);
#else
    for (int p = 0; p < NPHASE; ++p) {
        if (p == 7) continue;
        a.ph_lo = p; a.ph_hi = (p == 6) ? 8 : p + 1;
        hipLaunchKernelGGL(fwd_kernel, dim3(grid), dim3(512), LDS_BYTES, stream, a);
    }
#endif
}
```

```cpp
#include <hip/hip_runtime.h>
#include <hip/hip_cooperative_groups.h>
#include <cstdio>
#include <cstdint>
namespace cg = cooperative_groups;

#ifndef HDUP_MASK
#define HDUP_MASK 0x0
#endif
#ifndef MK_N_LAUNCHES
#define MK_N_LAUNCHES 1
#endif

#define LAS __attribute__((address_space(3)))
#define DI __device__ __forceinline__
typedef unsigned short bf16_t;
typedef short bf16x8 __attribute__((ext_vector_type(8)));
typedef float f32x4 __attribute__((ext_vector_type(4)));
typedef float f32x2 __attribute__((ext_vector_type(2)));
typedef unsigned u32x4 __attribute__((ext_vector_type(4)));
typedef unsigned u32x2 __attribute__((ext_vector_type(2)));

constexpr int DM = 1024, NB = 2, SEQ = 8192, NMETA = 16, TT = SEQ + NMETA;
constexpr int CH = 128, MPAD = CH - NMETA;
constexpr int LP = TT + MPAD;
constexpr int NCH = LP / CH;
constexpr int MP = NB * LP;
constexpr int MS = NB * SEQ;
constexpr int RH = 4, RDK = 128, RDV = 256, AH = 8, AG = 2, AHD = 128;
constexpr int DIN = 7680, NA = 3584, NGATE = 4096;
constexpr float EPSF = 1e-6f;
constexpr float LOG2E = 1.4426950408889634f;

constexpr size_t OFF_RQ = 0;
constexpr size_t OFF_RK = OFF_RQ + (size_t)MP * 512 * 2;
constexpr size_t OFF_RV = OFF_RK + (size_t)MP * 512 * 2;
constexpr size_t OFF_AQ = OFF_RV + (size_t)MP * 1024 * 2;
constexpr size_t OFF_AK = OFF_AQ + (size_t)MP * 1024 * 2;
constexpr size_t OFF_AV = OFF_AK + (size_t)MP * 256 * 2;
constexpr size_t OFF_KVS = OFF_AV + (size_t)MP * 256 * 2;
constexpr size_t KVS_BYTES = (size_t)2 * NB * NCH * RH * 32768 * 2;
constexpr size_t OFF_OR = OFF_KVS + KVS_BYTES;
constexpr size_t OFF_OA = OFF_OR + (size_t)MS * 1024 * 2;
constexpr size_t WS_END = OFF_OA + (size_t)MS * 1024 * 2;
constexpr size_t OFF_SGR = OFF_RQ, OFF_SGA = OFF_RQ + (size_t)MS * 1024 * 2;
constexpr size_t OFF_MIX = OFF_AQ;
constexpr size_t OFF_PART = OFF_KVS;
constexpr size_t OFF_OUT = OFF_OR;
static_assert(OFF_SGA + (size_t)MS * 1024 * 2 <= OFF_AQ, "gate overlay");
static_assert((size_t)MS * 1024 * 4 <= KVS_BYTES, "part overlay");
constexpr size_t OFF_CTL = WS_END;
constexpr size_t CTL_BYTES = 16384;
static_assert(OFF_CTL + CTL_BYTES <= 268435456ull, "ws");
constexpr size_t DO_U = 0;
constexpr size_t DO_WIN = DO_U + (size_t)MP * 1024 * 2;
constexpr size_t DO_WRB = DO_WIN + (size_t)DIN * 1024 * 2;
constexpr size_t DO_WAB = DO_WRB + (size_t)1024 * 1024 * 2;
constexpr size_t DO_WO = DO_WAB + (size_t)1024 * 1024 * 2;
constexpr size_t DO_CS = DO_WO + (size_t)1024 * 1024 * 2;
static_assert(DO_CS + (size_t)TT * 64 * 8 <= (size_t)MS * 1024 * 4, "d_out scratch");

constexpr int LDS_BYTES = 147456;
constexpr int LDT = 136;

typedef __bf16 bf16v2 __attribute__((ext_vector_type(2)));
DI unsigned cvt_pk_bf16(float lo, float hi) { const f32x2 v = {lo, hi}; const bf16v2 b = __builtin_convertvector(v, bf16v2); return __builtin_bit_cast(unsigned, b); }
DI float bf2f(unsigned short b) { return __uint_as_float(((unsigned)b) << 16); }
DI float bflo(unsigned w) { return __uint_as_float(w << 16); }
DI float bfhi(unsigned w) { return __uint_as_float(w & 0xffff0000u); }
DI float wave_sum(float v) {
#pragma unroll
    for (int o = 1; o < 64; o <<= 1) v += __shfl_xor(v, o);
    return v;
}
DI f32x4 mfma16(bf16x8 a, bf16x8 b, f32x4 c) { return __builtin_amdgcn_mfma_f32_16x16x32_bf16(a, b, c, 0, 0, 0); }
#define LDS_WAIT() asm volatile("s_waitcnt lgkmcnt(0)" ::: "memory")

namespace pg8 {
constexpr int BM = 256, BK = 64, HALF = 128, HTB = HALF * BK * 2, STAGE_BYTES = 8 * HTB, NXCD = 8, WGM = 8;
DI int lds_byte(int r, int c) { const int st = (r >> 4) * 2 + (c >> 5), rr = r & 15, cc = c & 31, ob = rr * 64 + cc * 2; return st * 1024 + (ob ^ (((ob >> 9) & 1) << 5)); }
DI void stage_rc(int b, int& R, int& C) { const int st = b / 1024, sb = b % 1024, swz = sb ^ (((sb >> 9) & 1) << 5); R = (st >> 1) * 16 + swz / 64; C = (st & 1) * 32 + (swz % 64) / 2; }
struct Unit { int pm, pn; };
struct Gemm { const bf16_t* A; const bf16_t* Bt; int M, N, K, amode; };
DI size_t a_row0(const Gemm& g, int pm) { return g.amode ? (size_t)((pm >> 5) * LP + 128 + (pm & 31) * 256) : (size_t)pm * 256; }
struct StaticOrder {
    int nM, nN, nwg, G, c;
    DI void init(int M, int N, int G_, int c_) { nM = M / BM; nN = N / BM; nwg = nM * nN; G = G_; c = c_; }
    DI bool next(int i, Unit& u) const {
        const long L = (long)i * G + c; if (L >= nwg) return false;
        int wgid = (int)L; { const int q = nwg / NXCD, r = nwg % NXCD, xcd = wgid % NXCD, off = wgid / NXCD; wgid = (xcd < r ? xcd * (q + 1) : r * (q + 1) + (xcd - r) * q) + off; }
        const int nig = WGM * nN, gid = wgid / nig, fm = gid * WGM, gsz = (nM - fm) < WGM ? (nM - fm) : WGM;
        u.pm = fm + ((wgid % nig) % gsz); u.pn = (wgid % nig) / gsz; return true;
    }
};
template <class Epi, bool ALIGN_EPI>
DI void gemm_phase(LAS unsigned char* lds, const Gemm g, const StaticOrder& S, const Epi& E) {
    const int tid = threadIdx.x, wid = __builtin_amdgcn_readfirstlane(tid >> 6), lane = tid & 63, wr = wid >> 2, wc = wid & 3, fr = lane & 15, fq = lane >> 4;
    const int K = g.K, nt = K / BK;
    unsigned voffA[2];
#pragma unroll
    for (int i = 0; i < 2; ++i) { int R, C; stage_rc(tid * 16 + i * 8192, R, C); voffA[i] = (unsigned)(R * K + C) * 2u; }
    const size_t kstep = (size_t)(BK * 2);
    const size_t hstep = (size_t)HALF * K * 2;
    const size_t tstep = 2 * hstep;
    const size_t rowb = (size_t)K * 2;
    const unsigned ldsw = (unsigned)wid * 1024u;
    const int aoff = lds_byte(wr * 64 + fr, fq * 8), boff = lds_byte(wc * 32 + fr, fq * 8);
#define PG8_SA(b, h) (((b) * 2 + (h)) * HTB)
#define PG8_SB(b, h) ((4 + (b) * 2 + (h)) * HTB)
#define PG8_STAGE(bufoff, gbase, voff) do { _Pragma("unroll") for (int _i = 0; _i < 2; ++_i) \
        __builtin_amdgcn_global_load_lds((const unsigned*)((const char*)(gbase) + (voff)[_i]), (LAS unsigned*)(lds + (bufoff) + ldsw + _i * 8192), 16, 0, 0); } while (0)
#define PG8_LDA(dst, b, h) do { _Pragma("unroll") for (int m = 0; m < 4; ++m) _Pragma("unroll") for (int k = 0; k < 2; ++k) dst[m][k] = *(const LAS bf16x8*)(lds + PG8_SA(b, h) + aoff + m * 2048 + k * 1024); } while (0)
#define PG8_LDB(dst, b, h) do { _Pragma("unroll") for (int n = 0; n < 2; ++n) _Pragma("unroll") for (int k = 0; k < 2; ++k) dst[n][k] = *(const LAS bf16x8*)(lds + PG8_SB(b, h) + boff + n * 2048 + k * 1024); } while (0)
#define PG8_MMA(ai, bj, At, Bt) do { __builtin_amdgcn_s_setprio(1); _Pragma("unroll") for (int m = 0; m < 4; ++m) _Pragma("unroll") for (int n = 0; n < 2; ++n) _Pragma("unroll") for (int k = 0; k < 2; ++k) \
        acc[ai][bj][m][n] = __builtin_amdgcn_mfma_f32_16x16x32_bf16(Bt[n][k], At[m][k], acc[ai][bj][m][n], 0, 0, 0); __builtin_amdgcn_s_setprio(0); } while (0)
#define PG8_WAIT_V(n) asm volatile("s_waitcnt vmcnt(" #n ")" ::: "memory")
#define PG8_WAIT_L(n) asm volatile("s_waitcnt lgkmcnt(" #n ")" ::: "memory")
#define PG8_BAR __builtin_amdgcn_s_barrier()
#define PG8_SCHED __builtin_amdgcn_sched_barrier(0)
    Unit cur, nxt; int ui = 0;
    if (!S.next(0, cur)) return;
    f32x4 acc[2][2][4][2];
#pragma unroll
    for (int a = 0; a < 2; ++a)
#pragma unroll
        for (int b = 0; b < 2; ++b)
#pragma unroll
            for (int m = 0; m < 4; ++m)
#pragma unroll
                for (int n = 0; n < 2; ++n) acc[a][b][m][n] = (f32x4){0.f, 0.f, 0.f, 0.f};
    bf16x8 At[4][2], B0[2][2], B1[2][2];
    const char* cA = (const char*)g.A + a_row0(g, cur.pm) * rowb; const char* cB = (const char*)g.Bt + (size_t)cur.pn * tstep;
    PG8_STAGE(PG8_SB(0, 0), cB, voffA); PG8_STAGE(PG8_SB(0, 1), cB + hstep, voffA); PG8_STAGE(PG8_SA(0, 0), cA, voffA); PG8_STAGE(PG8_SA(0, 1), cA + hstep, voffA);
    if (wr == 1) PG8_BAR;
    PG8_WAIT_V(2); PG8_BAR;
    PG8_STAGE(PG8_SB(1, 0), cB + kstep, voffA); PG8_STAGE(PG8_SA(1, 0), cA + kstep, voffA); PG8_STAGE(PG8_SB(1, 1), cB + hstep + kstep, voffA);
    PG8_WAIT_V(6); PG8_BAR;
    for (;;) {
        const bool has_next = S.next(ui + 1, nxt);
        const char* nA = has_next ? (const char*)g.A + a_row0(g, nxt.pm) * rowb : cA; const char* nB = has_next ? (const char*)g.Bt + (size_t)nxt.pn * tstep : cB;
        for (int t = 0; t < nt; t += 2) {
            const bool last = (t == nt - 2);
            const char* a1 = cA + (size_t)(t + 1) * kstep;
            const char* a2 = last ? nA : cA + (size_t)(t + 2) * kstep; const char* b2 = last ? nB : cB + (size_t)(t + 2) * kstep;
            const char* a3 = a2 + kstep; const char* b3 = b2 + kstep;
            PG8_LDB(B0, 0, 0); PG8_LDB(B1, 0, 1); PG8_SCHED; PG8_LDA(At, 0, 0); PG8_STAGE(PG8_SA(1, 1), a1 + hstep, voffA);
            PG8_WAIT_V(8); PG8_WAIT_L(0); PG8_BAR; PG8_MMA(0, 0, At, B0); PG8_MMA(0, 1, At, B1); PG8_BAR; PG8_SCHED;
            PG8_LDA(At, 0, 1); PG8_STAGE(PG8_SB(0, 0), b2, voffA); PG8_STAGE(PG8_SB(0, 1), b2 + hstep, voffA); PG8_STAGE(PG8_SA(0, 0), a2, voffA);
            PG8_WAIT_V(8); PG8_WAIT_L(0); PG8_BAR; PG8_MMA(1, 0, At, B0); PG8_MMA(1, 1, At, B1); PG8_BAR; PG8_SCHED;
            PG8_LDB(B0, 1, 0); PG8_LDB(B1, 1, 1); PG8_SCHED; PG8_LDA(At, 1, 0); PG8_STAGE(PG8_SA(0, 1), a2 + hstep, voffA);
            PG8_WAIT_V(8); PG8_WAIT_L(0); PG8_BAR; PG8_MMA(0, 0, At, B0); PG8_MMA(0, 1, At, B1); PG8_BAR; PG8_SCHED;
            PG8_LDA(At, 1, 1); PG8_STAGE(PG8_SB(1, 0), b3, voffA); PG8_STAGE(PG8_SB(1, 1), b3 + hstep, voffA); PG8_STAGE(PG8_SA(1, 0), a3, voffA);
            PG8_WAIT_V(8); PG8_WAIT_L(0); PG8_BAR; PG8_MMA(1, 0, At, B0); PG8_MMA(1, 1, At, B1); PG8_BAR; PG8_SCHED;
        }
        if constexpr (ALIGN_EPI) { if (wr == 0) PG8_BAR; }
        E(acc, cur, wr, wc, fr, fq);
        if (!has_next) break;
#pragma unroll
        for (int a = 0; a < 2; ++a)
#pragma unroll
            for (int b = 0; b < 2; ++b)
#pragma unroll
                for (int m = 0; m < 4; ++m)
#pragma unroll
                    for (int n = 0; n < 2; ++n) acc[a][b][m][n] = (f32x4){0.f, 0.f, 0.f, 0.f};
        cur = nxt; cA = nA; cB = nB; ++ui;
        if constexpr (ALIGN_EPI) { if (wr == 1) PG8_BAR; }
    }
    PG8_WAIT_V(0);
    if constexpr (!ALIGN_EPI) { if (wr == 0) PG8_BAR; }
    PG8_BAR;
#undef PG8_SA
#undef PG8_SB
#undef PG8_STAGE
#undef PG8_LDA
#undef PG8_LDB
#undef PG8_MMA
#undef PG8_WAIT_V
#undef PG8_WAIT_L
#undef PG8_BAR
#undef PG8_SCHED
}
}

typedef f32x4 Acc[2][2][4][2];
struct EpiA {
    unsigned char* ws; const float* cs;
    DI void operator()(const Acc& acc, const pg8::Unit& u, int wr, int wc, int fr, int fq) const {
        const int pn = u.pn; size_t off; int ld, colb, rot; float sc;
        if (pn < 2) { off = OFF_RQ; ld = 512; colb = pn * 256; rot = 1; sc = 1.f; }
        else if (pn < 4) { off = OFF_RK; ld = 512; colb = (pn - 2) * 256; rot = 1; sc = 0.08838834764831845f; }
        else if (pn < 8) { off = OFF_RV; ld = 1024; colb = (pn - 4) * 256; rot = 0; sc = 1.f; }
        else if (pn < 12) { off = OFF_AQ; ld = 1024; colb = (pn - 8) * 256; rot = 1; sc = 0.08838834764831845f * LOG2E; }
        else if (pn == 12) { off = OFF_AK; ld = 256; colb = 0; rot = 1; sc = 1.f; }
        else { off = OFF_AV; ld = 256; colb = 0; rot = 0; sc = 1.f; }
        bf16_t* dst = (bf16_t*)(ws + off);
#pragma unroll
        for (int ai = 0; ai < 2; ++ai)
#pragma unroll
            for (int m = 0; m < 4; ++m) {
                const int r = u.pm * 256 + ai * 128 + wr * 64 + m * 16 + fr;
                const int p = r >= LP ? r - LP : r; const int t = p >= MPAD ? p - MPAD : 0;
                f32x4 c4 = (f32x4){sc, sc, sc, sc}, s4 = (f32x4){0.f, 0.f, 0.f, 0.f};
                if (rot) { const f32x4* pc = (const f32x4*)(cs + ((size_t)t * 64 + 16 * wc + 4 * fq) * 2); const f32x4 x0 = pc[0], x1 = pc[1];
                    c4 = (f32x4){x0[0], x0[2], x1[0], x1[2]} * sc; s4 = (f32x4){x0[1], x0[3], x1[1], x1[3]} * sc; }
                bf16_t* rowp = dst + (size_t)r * ld + colb + 16 * wc + 4 * fq;
#pragma unroll
                for (int bj = 0; bj < 2; ++bj) {
                    const f32x4 v0 = acc[ai][bj][m][0], v1 = acc[ai][bj][m][1];
                    const f32x4 o0 = v0 * c4 - v1 * s4, o1 = v1 * c4 + v0 * s4;
                    u32x2 w0, w1; w0.x = cvt_pk_bf16(o0[0], o0[1]); w0.y = cvt_pk_bf16(o0[2], o0[3]); w1.x = cvt_pk_bf16(o1[0], o1[1]); w1.y = cvt_pk_bf16(o1[2], o1[3]);
                    *(u32x2*)(rowp + bj * 128) = w0; *(u32x2*)(rowp + bj * 128 + 64) = w1;
                }
            }
    }
};
DI float sigmoidf_(float x) { return __builtin_amdgcn_rcpf(1.f + __expf(-x)); }
struct EpiGate {
    unsigned char* ws; int dry;
    DI void operator()(const Acc& acc, const pg8::Unit& u, int wr, int wc, int fr, int fq) const {
        const int seg = u.pn >> 2, colb = (u.pn & 3) * 256;
        bf16_t* dst = (bf16_t*)(ws + (seg == 0 ? OFF_OR : seg == 1 ? OFF_OA : seg == 2 ? OFF_SGR : OFF_SGA));
#pragma unroll
        for (int ai = 0; ai < 2; ++ai)
#pragma unroll
            for (int m = 0; m < 4; ++m) {
                const int r = u.pm * 256 + ai * 128 + wr * 64 + m * 16 + fr;
#pragma unroll
                for (int bj = 0; bj < 2; ++bj)
#pragma unroll
                    for (int n = 0; n < 2; ++n) {
                        bf16_t* p = dst + (size_t)r * 1024 + colb + bj * 128 + wc * 32 + n * 16 + 4 * fq;
                        const f32x4 a = acc[ai][bj][m][n]; f32x4 o;
#pragma unroll
                        for (int e = 0; e < 4; ++e) o[e] = sigmoidf_(a[e]);
                        if (seg < 2) { const u32x2 w = *(const u32x2*)p; o = o * a; if (dry) o = (f32x4){1.f, 1.f, 1.f, 1.f}; o[0] *= bflo(w.x); o[1] *= bfhi(w.x); o[2] *= bflo(w.y); o[3] *= bfhi(w.y); }
                        u32x2 w2; w2.x = cvt_pk_bf16(o[0], o[1]); w2.y = cvt_pk_bf16(o[2], o[3]); *(u32x2*)p = w2;
                    }
            }
    }
};
template <int MODE> struct EpiPost {
    unsigned char* ws;
    DI void operator()(const Acc& acc, const pg8::Unit& u, int wr, int wc, int fr, int fq) const {
#pragma unroll
        for (int ai = 0; ai < 2; ++ai)
#pragma unroll
            for (int m = 0; m < 4; ++m) {
                const int r = u.pm * 256 + ai * 128 + wr * 64 + m * 16 + fr;
#pragma unroll
                for (int bj = 0; bj < 2; ++bj)
#pragma unroll
                    for (int n = 0; n < 2; ++n) {
                        const size_t idx = (size_t)r * 1024 + u.pn * 256 + bj * 128 + wc * 32 + n * 16 + 4 * fq;
                        const f32x4 a = acc[ai][bj][m][n];
                        if (MODE == 2) { *(f32x4*)((float*)(ws + OFF_OUT) + idx) = a; }
                        else {
                            const u32x2 w = *(const u32x2*)((const bf16_t*)(ws + (MODE == 0 ? OFF_SGR : OFF_SGA)) + idx);
                            f32x4 o = (f32x4){a[0] * bflo(w.x), a[1] * bfhi(w.x), a[2] * bflo(w.y), a[3] * bfhi(w.y)};
                            if (MODE == 0) { *(f32x4*)((float*)(ws + OFF_PART) + idx) = o; }
                            else { o = o + *(const f32x4*)((const float*)(ws + OFF_PART) + idx);
                                u32x2 w2; w2.x = cvt_pk_bf16(o[0], o[1]); w2.y = cvt_pk_bf16(o[2], o[3]); *(u32x2*)((bf16_t*)(ws + OFF_MIX) + idx) = w2; }
                        }
                    }
            }
    }
};

struct Args {
    const float* x; const float* meta; const float* pre_w; const float* w_in; const float* dec_f; const float* dec_b; const float* ret_nw;
    const float* w_rb; const float* sink; const float* w_ab; const float* w_o; const float* post_w;
    float* out; unsigned char* ws; int ph_lo, ph_hi, dry, pad_;
};

DI int win_dst_row(int c) {
    int d;
    if (c < 2048) d = c; else if (c < 3072) d = 3584 + (c - 2048); else if (c < 4608) d = 2048 + (c - 3072); else d = c;
    if (d < NA) { const int q = d & 127; d = (d & ~127) + 32 * ((q >> 4) & 3) + 16 * (q >> 6) + (q & 15); }
    return d;
}
template <bool WIN>
DI void p0_transpose_item(const float* W, int K, int N, bf16_t* WT, LAS float* scr, int item, int lane) {
    const int nblk = N / 32, kb = item / nblk, nb = item % nblk, k0 = 64 * kb, n0 = 32 * nb;
#pragma unroll 8
    for (int i = 0; i < 32; ++i) { const int kk = 2 * i + (lane >> 5); scr[kk * 33 + (lane & 31)] = W[(size_t)(k0 + kk) * N + n0 + (lane & 31)]; }
    LDS_WAIT();
    const int c = lane & 7;
#pragma unroll
    for (int j = 0; j < 4; ++j) { const int n = (lane >> 3) + 8 * j; const LAS float* s = scr + (8 * c) * 33 + n;
        u32x4 o; o.x = cvt_pk_bf16(s[0 * 33], s[1 * 33]); o.y = cvt_pk_bf16(s[2 * 33], s[3 * 33]); o.z = cvt_pk_bf16(s[4 * 33], s[5 * 33]); o.w = cvt_pk_bf16(s[6 * 33], s[7 * 33]);
        const int drow = WIN ? win_dst_row(n0 + n) : (n0 + n);
        *(u32x4*)(WT + (size_t)drow * K + k0 + 8 * c) = o; }
    LDS_WAIT();
}
DI void phase_prologue(LAS unsigned char* lds, const Args& A) {
    const int tid = threadIdx.x, lane = tid & 63, wave = tid >> 6;
    const int gw = blockIdx.x * 8 + wave, NGW = gridDim.x * 8;
    unsigned char* dob = (unsigned char*)A.out;
    LAS float* scr = (LAS float*)(lds + wave * 16384);
    constexpr int I_IN = (DM / 64) * (DIN / 32), I_SQ = (DM / 64) * (DM / 32);
    for (int it = gw; it < I_IN + 3 * I_SQ; it += NGW) {
        int r = it;
        if (r < I_IN) { p0_transpose_item<true>(A.w_in, DM, DIN, (bf16_t*)(dob + DO_WIN), scr, r, lane); continue; } r -= I_IN;
        if (r < I_SQ) { p0_transpose_item<false>(A.w_rb, DM, DM, (bf16_t*)(dob + DO_WRB), scr, r, lane); continue; } r -= I_SQ;
        if (r < I_SQ) { p0_transpose_item<false>(A.w_ab, DM, DM, (bf16_t*)(dob + DO_WAB), scr, r, lane); continue; } r -= I_SQ;
        p0_transpose_item<false>(A.w_o, DM, DM, (bf16_t*)(dob + DO_WO), scr, r, lane);
    }
    bf16_t* U = (bf16_t*)(dob + DO_U);
    for (int r = gw; r < MP; r += NGW) {
        const int b = r >= LP ? 1 : 0, p = r - b * LP;
        u32x2* o8 = (u32x2*)(U + (size_t)r * DM) + lane;
        if (p < MPAD) {
#pragma unroll
            for (int j = 0; j < 4; ++j) o8[64 * j] = (u32x2){0u, 0u};
            continue; }
        const int t = p - MPAD;
        const float* src = t < NMETA ? A.meta + (size_t)t * DM : A.x + ((size_t)b * SEQ + (t - NMETA)) * DM;
        const f32x4* xr = (const f32x4*)src + lane; const f32x4* wr4 = (const f32x4*)A.pre_w + lane;
        f32x4 v[4]; float s = 0.f;
#pragma unroll
        for (int j = 0; j < 4; ++j) { v[j] = xr[64 * j]; s += (v[j][0] * v[j][0] + v[j][1] * v[j][1]) + (v[j][2] * v[j][2] + v[j][3] * v[j][3]); }
        const float rs = rsqrtf(wave_sum(s) * (1.f / DM) + EPSF);
#pragma unroll
        for (int j = 0; j < 4; ++j) { const f32x4 w = wr4[64 * j]; const f32x4 y = v[j] * rs * w; o8[64 * j] = (u32x2){cvt_pk_bf16(y[0], y[1]), cvt_pk_bf16(y[2], y[3])}; }
    }
    float* cs = (float*)(dob + DO_CS);
    for (int i = blockIdx.x * 512 + tid; i < TT * 64; i += gridDim.x * 512) {
        const int t = i >> 6, f = i & 63;
        const float inv = (float)exp2(-(double)f * (2.0 / 128.0) * 13.287712379549449);
        const float ang = (float)t * inv;
        double rev = (double)ang * 0.15915494309189535; rev -= floor(rev);
        const float fr = (float)rev;
        cs[2 * i] = __builtin_amdgcn_cosf(fr); cs[2 * i + 1] = __builtin_amdgcn_sinf(fr);
    }
}

template <int ROWS> DI void stage_plain(LAS bf16_t* dst, const bf16_t* src, int ld, int tid) {
#pragma unroll
    for (int i = 0; i < ROWS / 32; ++i) { const int id = tid + 512 * i, row = id >> 4, c8 = id & 15;
        const u32x4 v = *(const u32x4*)(src + (size_t)row * ld + c8 * 8); *(LAS u32x4*)(dst + row * LDT + c8 * 8) = v; }
}
template <int NCOLS> DI void stage_transposed(LAS bf16_t* dst, const bf16_t* src, int ld, int tid) {
    const int j = tid & 127;
#pragma unroll
    for (int i = 0; i < NCOLS / 32; ++i) { const int g8 = (tid >> 7) + 4 * i;
        const u32x4 v = *(const u32x4*)(src + (size_t)j * ld + g8 * 8);
        LAS bf16_t* d = dst + (g8 * 8) * LDT + j;
        d[0 * LDT] = (bf16_t)(v.x & 0xffff); d[1 * LDT] = (bf16_t)(v.x >> 16); d[2 * LDT] = (bf16_t)(v.y & 0xffff); d[3 * LDT] = (bf16_t)(v.y >> 16);
        d[4 * LDT] = (bf16_t)(v.z & 0xffff); d[5 * LDT] = (bf16_t)(v.z >> 16); d[6 * LDT] = (bf16_t)(v.w & 0xffff); d[7 * LDT] = (bf16_t)(v.w >> 16); }
}
DI bf16x8 scale_frag(bf16x8 a, float s) {
    const u32x4 w = __builtin_bit_cast(u32x4, a); u32x4 o;
    o.x = cvt_pk_bf16(bflo(w.x) * s, bfhi(w.x) * s); o.y = cvt_pk_bf16(bflo(w.y) * s, bfhi(w.y) * s);
    o.z = cvt_pk_bf16(bflo(w.z) * s, bfhi(w.z) * s); o.w = cvt_pk_bf16(bflo(w.w) * s, bfhi(w.w) * s);
    return __builtin_bit_cast(bf16x8, o);
}
DI float log2_sigmoid(float d) { return -log2f(1.f + expf(-d)); }
DI size_t kvs_off(int dir, int b, int n, int h) { return ((((size_t)dir * NB + b) * NCH + n) * RH + h) * 32768; }

DI void ret_kv_unit(LAS unsigned char* lds, const Args& A, int b, int n, int h) {
    const int tid = threadIdx.x, lane = tid & 63, w = tid >> 6, fr = lane & 15, fq = lane >> 4;
    LAS bf16_t* Vt = (LAS bf16_t*)lds;
    LAS bf16_t* Kf = Vt + 256 * LDT;
    LAS bf16_t* Kb = Kf + 128 * LDT;
    const float lgf = log2_sigmoid(A.dec_f[h]), lgb = log2_sigmoid(A.dec_b[h]);
    const size_t row0 = (size_t)b * LP + (size_t)n * CH;
    const bf16_t* RK = (const bf16_t*)(A.ws + OFF_RK) + row0 * 512 + h * 128;
    const bf16_t* RV = (const bf16_t*)(A.ws + OFF_RV) + row0 * 1024 + h * 256;
    stage_transposed<256>(Vt, RV, 1024, tid);
    {
        const int j = tid & 127; const float wf = exp2f((float)(127 - j) * lgf), wb = exp2f((float)j * lgb);
#pragma unroll
        for (int i = 0; i < 4; ++i) { const int g8 = (tid >> 7) + 4 * i;
            const u32x4 v = *(const u32x4*)(RK + (size_t)j * 512 + g8 * 8);
            float f[8] = {bflo(v.x), bfhi(v.x), bflo(v.y), bfhi(v.y), bflo(v.z), bfhi(v.z), bflo(v.w), bfhi(v.w)};
#pragma unroll
            for (int e = 0; e < 8; ++e) { Kf[(g8 * 8 + e) * LDT + j] = (bf16_t)(cvt_pk_bf16(f[e] * wf, 0.f) & 0xffff); Kb[(g8 * 8 + e) * LDT + j] = (bf16_t)(cvt_pk_bf16(f[e] * wb, 0.f) & 0xffff); } }
    }
    __syncthreads();
#pragma unroll 1
    for (int dir = 0; dir < 2; ++dir) {
        const LAS bf16_t* Kx = dir ? Kb : Kf;
        f32x4 aF[2][8];
#pragma unroll
        for (int mt = 0; mt < 2; ++mt)
#pragma unroll
            for (int nt = 0; nt < 8; ++nt) aF[mt][nt] = (f32x4){0.f, 0.f, 0.f, 0.f};
#pragma unroll
        for (int ks = 0; ks < 4; ++ks) {
            bf16x8 a[2];
#pragma unroll
            for (int mt = 0; mt < 2; ++mt) a[mt] = *(const LAS bf16x8*)(Vt + (32 * w + 16 * mt + fr) * LDT + ks * 32 + fq * 8);
#pragma unroll
            for (int nt = 0; nt < 8; ++nt) {
                const bf16x8 bf = *(const LAS bf16x8*)(Kx + (16 * nt + fr) * LDT + ks * 32 + fq * 8);
#pragma unroll
                for (int mt = 0; mt < 2; ++mt) aF[mt][nt] = mfma16(bf, a[mt], aF[mt][nt]);
            }
        }
        bf16_t* of = (bf16_t*)(A.ws + OFF_KVS) + kvs_off(dir, b, n, h);
#pragma unroll
        for (int mt = 0; mt < 2; ++mt)
#pragma unroll
            for (int nt = 0; nt < 8; ++nt) { const int o = (32 * w + 16 * mt + fr) * 128 + 16 * nt + 4 * fq;
                *(u32x2*)(of + o) = (u32x2){cvt_pk_bf16(aF[mt][nt][0], aF[mt][nt][1]), cvt_pk_bf16(aF[mt][nt][2], aF[mt][nt][3])}; }
    }
    __syncthreads();
}

DI void phase_scan(const Args& A) {
    bf16_t* KVS = (bf16_t*)(A.ws + OFF_KVS);
    for (int idx = blockIdx.x * 512 + threadIdx.x; idx < 2 * NB * RH * 8192; idx += gridDim.x * 512) {
        const int e4 = idx & 8191, h = (idx >> 13) & 3, b = (idx >> 15) & 1, dir = idx >> 16;
        const float lg = log2_sigmoid(dir ? A.dec_b[h] : A.dec_f[h]); const float cd = exp2f(128.f * lg);
        f32x4 S = (f32x4){0.f, 0.f, 0.f, 0.f};
#pragma unroll 1
        for (int g = 0; g < 5; ++g) {
            u32x2 v[13];
#pragma unroll
            for (int k = 0; k < 13; ++k) { const int s = g * 13 + k, n = dir ? (NCH - 1 - s) : s; v[k] = *(const u32x2*)(KVS + kvs_off(dir, b, n, h) + (size_t)e4 * 4); }
#pragma unroll
            for (int k = 0; k < 13; ++k) { const int s = g * 13 + k, n = dir ? (NCH - 1 - s) : s;
                *(u32x2*)(KVS + kvs_off(dir, b, n, h) + (size_t)e4 * 4) = A.dry ? v[k] : (u32x2){cvt_pk_bf16(S[0], S[1]), cvt_pk_bf16(S[2], S[3])};
                S = S * cd + (f32x4){bflo(v[k].x), bfhi(v[k].x), bflo(v[k].y), bfhi(v[k].y)}; }
        }
    }
}

DI void ret_out_unit(LAS unsigned char* lds, const Args& A, int b, int n, int h) {
    const int tid = threadIdx.x, lane = tid & 63, w = tid >> 6, fr = lane & 15, fq = lane >> 4;
    LAS bf16_t* Kt = (LAS bf16_t*)lds;
    LAS bf16_t* Vt = Kt + 128 * LDT;
    LAS bf16_t* Pw = Vt + 256 * LDT + w * 16 * LDT;
    const float lgf = log2_sigmoid(A.dec_f[h]), lgb = log2_sigmoid(A.dec_b[h]);
    const size_t row0 = (size_t)b * LP + (size_t)n * CH;
    const int i = 16 * w + fr;
    bf16x8 q[4];
    { const bf16_t* qp = (const bf16_t*)(A.ws + OFF_RQ) + (row0 + i) * 512 + h * 128 + fq * 8;
#pragma unroll
      for (int ks = 0; ks < 4; ++ks) q[ks] = *(const bf16x8*)(qp + ks * 32); }
    stage_plain<128>(Kt, (const bf16_t*)(A.ws + OFF_RK) + row0 * 512 + h * 128, 512, tid);
    stage_transposed<256>(Vt, (const bf16_t*)(A.ws + OFF_RV) + row0 * 1024 + h * 256, 1024, tid);
    __syncthreads();
    f32x4 S[8];
#pragma unroll
    for (int nt = 0; nt < 8; ++nt) S[nt] = (f32x4){0.f, 0.f, 0.f, 0.f};
#pragma unroll
    for (int ks = 0; ks < 4; ++ks)
#pragma unroll
        for (int nt = 0; nt < 8; ++nt) S[nt] = mfma16(*(const LAS bf16x8*)(Kt + (16 * nt + fr) * LDT + ks * 32 + fq * 8), q[ks], S[nt]);
#pragma unroll
    for (int nt = 0; nt < 8; ++nt) {
#pragma unroll
        for (int e = 0; e < 4; ++e) { const int d = i - (16 * nt + 4 * fq + e); S[nt][e] *= d >= 0 ? exp2f((float)d * lgf) : exp2f((float)(-d) * lgb); }
        *(LAS u32x2*)(Pw + fr * LDT + 16 * nt + 4 * fq) = (u32x2){cvt_pk_bf16(S[nt][0], S[nt][1]), cvt_pk_bf16(S[nt][2], S[nt][3])};
    }
    LDS_WAIT();
    f32x4 O[16];
#pragma unroll
    for (int nt = 0; nt < 16; ++nt) O[nt] = (f32x4){0.f, 0.f, 0.f, 0.f};
#pragma unroll
    for (int ks = 0; ks < 4; ++ks) { const bf16x8 p = *(const LAS bf16x8*)(Pw + fr * LDT + ks * 32 + fq * 8);
#pragma unroll
        for (int nt = 0; nt < 16; ++nt) O[nt] = mfma16(*(const LAS bf16x8*)(Vt + (16 * nt + fr) * LDT + ks * 32 + fq * 8), p, O[nt]); }
#pragma unroll
    for (int dir = 0; dir < 2; ++dir) {
        __syncthreads();
        stage_plain<256>(Vt, (const bf16_t*)(A.ws + OFF_KVS) + kvs_off(dir, b, n, h), 128, tid);
        __syncthreads();
        const float qs = dir ? exp2f((float)(128 - i) * lgb) : exp2f((float)(i + 1) * lgf);
#pragma unroll
        for (int ks = 0; ks < 4; ++ks) { const bf16x8 p = scale_frag(q[ks], qs);
#pragma unroll
            for (int nt = 0; nt < 16; ++nt) O[nt] = mfma16(*(const LAS bf16x8*)(Vt + (16 * nt + fr) * LDT + ks * 32 + fq * 8), p, O[nt]); }
    }
    float s = 0.f;
#pragma unroll
    for (int nt = 0; nt < 16; ++nt) s += (O[nt][0] + O[nt][1]) + (O[nt][2] + O[nt][3]);
    s += __shfl_xor(s, 16); s += __shfl_xor(s, 32);
    const float mu = s * (1.f / 256.f); float q2 = 0.f;
#pragma unroll
    for (int nt = 0; nt < 16; ++nt) { const f32x4 d = O[nt] - mu; q2 += (d[0] * d[0] + d[1] * d[1]) + (d[2] * d[2] + d[3] * d[3]); }
    q2 += __shfl_xor(q2, 16); q2 += __shfl_xor(q2, 32);
    const float rstd = rsqrtf(q2 * (1.f / 256.f) + EPSF);
    bf16_t* orow = (bf16_t*)(A.ws + OFF_OR) + ((size_t)b * SEQ + (size_t)(n - 1) * CH + i) * 1024 + h * 256;
    const float* nw = A.ret_nw + h * 256;
#pragma unroll
    for (int nt = 0; nt < 16; ++nt) { const f32x4 wv = *(const f32x4*)(nw + 16 * nt + 4 * fq); const f32x4 y = (O[nt] - mu) * rstd * wv;
        *(u32x2*)(orow + 16 * nt + 4 * fq) = (u32x2){cvt_pk_bf16(y[0], y[1]), cvt_pk_bf16(y[2], y[3])}; }
    __syncthreads();
}

DI void attn_unit(LAS unsigned char* lds, const Args& A, int b, int g, int n, int half) {
    const int tid = threadIdx.x, lane = tid & 63, w = tid >> 6, fr = lane & 15, fq = lane >> 4;
    LAS bf16_t* Kt = (LAS bf16_t*)lds;
    LAS bf16_t* Vt = Kt + 128 * LDT;
    LAS bf16_t* Pw = Vt + 128 * LDT + w * 16 * LDT;
    const int head = g * 4 + (w >> 1), rbase = 64 * half + 32 * (w & 1);
    const float NEG = -1e30f;
    const float sinkl = A.sink[head] * LOG2E;
    f32x4 O[2][8]; float mrun[2], lrun[2];
#pragma unroll
    for (int mt = 0; mt < 2; ++mt) { mrun[mt] = sinkl; lrun[mt] = 1.f;
#pragma unroll
        for (int nt = 0; nt < 8; ++nt) O[mt][nt] = (f32x4){0.f, 0.f, 0.f, 0.f}; }
    const size_t qrow0 = (size_t)b * LP + (size_t)n * CH;
    const bf16_t* AQ = (const bf16_t*)(A.ws + OFF_AQ) + qrow0 * 1024 + head * 128 + fq * 8;
#pragma unroll 1
    for (int kt = 0; kt < 4; ++kt) {
        const int kc = kt == 3 ? 0 : n - 1 + kt;
        if ((kt == 0 && n < 2) || (kt == 2 && n > NCH - 2)) continue;
        const size_t krow0 = (size_t)b * LP + (size_t)kc * CH;
        __syncthreads();
        stage_plain<128>(Kt, (const bf16_t*)(A.ws + OFF_AK) + krow0 * 256 + g * 128, 256, tid);
        stage_transposed<128>(Vt, (const bf16_t*)(A.ws + OFF_AV) + krow0 * 256 + g * 128, 256, tid);
        __syncthreads();
#pragma unroll
        for (int mt = 0; mt < 2; ++mt) {
            const int ii = rbase + 16 * mt + fr;
            bf16x8 q[4];
#pragma unroll
            for (int ks = 0; ks < 4; ++ks) q[ks] = *(const bf16x8*)(AQ + (size_t)ii * 1024 + ks * 32);
            f32x4 S[8];
#pragma unroll
            for (int nt = 0; nt < 8; ++nt) S[nt] = (f32x4){0.f, 0.f, 0.f, 0.f};
#pragma unroll
            for (int ks = 0; ks < 4; ++ks)
#pragma unroll
                for (int nt = 0; nt < 8; ++nt) S[nt] = mfma16(*(const LAS bf16x8*)(Kt + (16 * nt + fr) * LDT + ks * 32 + fq * 8), q[ks], S[nt]);
            float mx = NEG;
#pragma unroll
            for (int nt = 0; nt < 8; ++nt)
#pragma unroll
                for (int e = 0; e < 4; ++e) { const int jj = 16 * nt + 4 * fq + e;
                    const bool ok = kt == 0 ? (jj >= ii) : kt == 1 ? true : kt == 2 ? (jj <= ii) : (jj >= MPAD);
                    S[nt][e] = ok ? S[nt][e] : NEG; mx = fmaxf(mx, S[nt][e]); }
            mx = fmaxf(mx, __shfl_xor(mx, 16)); mx = fmaxf(mx, __shfl_xor(mx, 32));
            const float mnew = fmaxf(mrun[mt], mx), alpha = exp2f(mrun[mt] - mnew);
            float rs = 0.f;
#pragma unroll
            for (int nt = 0; nt < 8; ++nt) {
#pragma unroll
                for (int e = 0; e < 4; ++e) { S[nt][e] = exp2f(S[nt][e] - mnew); rs += S[nt][e]; }
                *(LAS u32x2*)(Pw + fr * LDT + 16 * nt + 4 * fq) = (u32x2){cvt_pk_bf16(S[nt][0], S[nt][1]), cvt_pk_bf16(S[nt][2], S[nt][3])};
            }
            rs += __shfl_xor(rs, 16); rs += __shfl_xor(rs, 32);
            lrun[mt] = lrun[mt] * alpha + rs; mrun[mt] = mnew;
#pragma unroll
            for (int nt = 0; nt < 8; ++nt) O[mt][nt] = O[mt][nt] * alpha;
            LDS_WAIT();
#pragma unroll
            for (int ks = 0; ks < 4; ++ks) { const bf16x8 p = *(const LAS bf16x8*)(Pw + fr * LDT + ks * 32 + fq * 8);
#pragma unroll
                for (int nt = 0; nt < 8; ++nt) O[mt][nt] = mfma16(*(const LAS bf16x8*)(Vt + (16 * nt + fr) * LDT + ks * 32 + fq * 8), p, O[mt][nt]); }
            LDS_WAIT();
        }
    }
    bf16_t* OA = (bf16_t*)(A.ws + OFF_OA) + ((size_t)b * SEQ + (size_t)(n - 1) * CH) * 1024 + head * 128;
#pragma unroll
    for (int mt = 0; mt < 2; ++mt) { const float inv = 1.f / lrun[mt]; const int ii = rbase + 16 * mt + fr;
#pragma unroll
        for (int nt = 0; nt < 8; ++nt) { const f32x4 y = O[mt][nt] * inv;
            *(u32x2*)(OA + (size_t)ii * 1024 + 16 * nt + 4 * fq) = (u32x2){cvt_pk_bf16(y[0], y[1]), cvt_pk_bf16(y[2], y[3])}; } }
    __syncthreads();
}

DI void phase_final(const Args& A) {
    const int tid = threadIdx.x, lane = tid & 63, wave = tid >> 6;
    const float* OUT = (const float*)(A.ws + OFF_OUT);
    for (int r = blockIdx.x * 8 + wave; r < MS; r += gridDim.x * 8) {
        const f32x4* o4 = (const f32x4*)(OUT + (size_t)r * DM) + lane; const f32x4* x4 = (const f32x4*)(A.x + (size_t)r * DM) + lane;
        const f32x4* w4 = (const f32x4*)A.post_w + lane; f32x4* d4 = (f32x4*)(A.out + (size_t)r * DM) + lane;
        f32x4 v[4]; float s = 0.f;
#pragma unroll
        for (int j = 0; j < 4; ++j) { v[j] = o4[64 * j]; s += (v[j][0] * v[j][0] + v[j][1] * v[j][1]) + (v[j][2] * v[j][2] + v[j][3] * v[j][3]); }
        const float rs = rsqrtf(wave_sum(s) * (1.f / DM) + EPSF);
#pragma unroll
        for (int j = 0; j < 4; ++j) d4[64 * j] = x4[64 * j] + v[j] * rs * w4[64 * j];
    }
}


#define XB_TMO      128
#define XB_XCNT(j)  (256  + 64 * (j))
#define XB_XSUB(j)  (1280 + 64 * (j))
#define XB_XGEN(j)  (2304 + 64 * (j))
#define XB_TOP      3328
#define XB_TOPGEN   3392
#define XCD_BAR_WORDS 3456
#define XB_SPIN_CAP (1u << 18)
DI unsigned xb_ld(unsigned* p)              { return __hip_atomic_load(p, __ATOMIC_RELAXED, __HIP_MEMORY_SCOPE_AGENT); }
DI unsigned xb_add(unsigned* p, unsigned v) { return __hip_atomic_fetch_add(p, v, __ATOMIC_RELAXED, __HIP_MEMORY_SCOPE_AGENT); }
DI unsigned xb_xcc_id() { return (unsigned)__builtin_amdgcn_s_getreg((3 << 11) | 20) & 0xFu; }
#define XB_SPIN(cond, bar) do { unsigned _sp = 0; while (cond) { __builtin_amdgcn_s_sleep(1); \
    if ((++_sp & 255u) == 0u) { if (xb_ld(&(bar)[XB_TMO])) break; if (_sp > XB_SPIN_CAP) { atomicAdd(&(bar)[XB_TMO], 1u); break; } } } } while (0)
struct XcdBarrier { unsigned* bar; unsigned x; volatile LAS unsigned* st; };
DI XcdBarrier xcd_barrier_post(unsigned* bar, volatile LAS unsigned* st) {
    XcdBarrier b; b.bar = bar; b.x = xb_xcc_id(); b.st = st;
    if (threadIdx.x == 0) (void)xb_add(&bar[XB_XCNT(b.x)], 1u);
    return b;
}
DI void xcd_barrier_complete(unsigned* bar, unsigned x, unsigned& nloc, unsigned& nx) {
    const unsigned G = gridDim.x * gridDim.y * gridDim.z;
    unsigned sum, cnt, mine, sp = 0u;
    for (;;) {
        sum = 0u; cnt = 0u; mine = 0u;
#pragma unroll
        for (unsigned j = 0; j < 16; ++j) { const unsigned c = xb_ld(&bar[XB_XCNT(j)]); sum += c; cnt += (c > 0u) ? 1u : 0u; mine = (j == x) ? c : mine; }
        if (sum == G) break;
        __builtin_amdgcn_s_sleep(1);
        if ((++sp & 255u) == 0u) { if (xb_ld(&bar[XB_TMO])) break; if (sp > XB_SPIN_CAP) { atomicAdd(&bar[XB_TMO], 1u); break; } }
    }
    nloc = mine > 0u ? mine : 1u; nx = cnt > 0u ? cnt : 1u;
}
DI void xcd_barrier(const XcdBarrier& b) {
    asm volatile("s_waitcnt vmcnt(0)" ::: "memory");
    __syncthreads();
    if (threadIdx.x == 0) {
        unsigned* bar = b.bar;
        __builtin_amdgcn_s_waitcnt(0);
        unsigned nloc = b.st[0], nx = b.st[1];
        if (nloc == 0u) { xcd_barrier_complete(bar, b.x, nloc, nx); b.st[0] = nloc; b.st[1] = nx; }
        const unsigned old = xb_add(&bar[XB_XSUB(b.x)], 1u);
        const unsigned gen = old / nloc;
        if (old + 1u == (gen + 1u) * nloc) {
            __builtin_amdgcn_fence(__ATOMIC_RELEASE, "agent");
            asm volatile("s_waitcnt vmcnt(0)" ::: "memory");
            const unsigned og = xb_add(&bar[XB_TOP], 1u);
            const unsigned tg = og / nx;
            if (og + 1u == (tg + 1u) * nx) xb_add(&bar[XB_TOPGEN], 1u);
            else XB_SPIN(xb_ld(&bar[XB_TOPGEN]) == tg, bar);
            __builtin_amdgcn_fence(__ATOMIC_ACQUIRE, "agent");
            xb_add(&bar[XB_XGEN(b.x)], 1u);
            asm volatile("s_waitcnt vmcnt(0)" ::: "memory");
        } else {
            XB_SPIN(xb_ld(&bar[XB_XGEN(b.x)]) == gen, bar);
            __builtin_amdgcn_fence(__ATOMIC_ACQUIRE, "agent");
            asm volatile("s_waitcnt vmcnt(0)" ::: "memory");
        }
    }
    __syncthreads();
}

constexpr int NPHASE = 10;
__global__ void __launch_bounds__(512, 2) fwd_kernel(Args A) {
    extern __shared__ __attribute__((aligned(16))) unsigned char lds_raw[];
    LAS unsigned char* lds = (LAS unsigned char*)lds_raw;
    const int lo = A.ph_lo, hi = A.ph_hi, G = gridDim.x, bx = blockIdx.x;
    unsigned char* dob = (unsigned char*)A.out;
    volatile LAS unsigned* MISC = (volatile LAS unsigned*)(lds + LDS_BYTES - 256);
    if (threadIdx.x < 64) MISC[threadIdx.x] = 0u;
    __syncthreads();
    XcdBarrier bar; bar.bar = (unsigned*)(A.ws + OFF_CTL); bar.x = 0; bar.st = MISC + 8;
    if (hi - lo > 1) bar = xcd_barrier_post((unsigned*)(A.ws + OFF_CTL), MISC + 8);
    if (lo < 0) cg::this_grid().sync();
#ifndef PH_MASK
#define PH_MASK 0x3ff
#endif
#define IN(k) (((PH_MASK >> (k)) & 1) && lo <= (k) && (k) < hi)
#ifndef DUP_MASK
#define DUP_MASK 0
#endif
#define REP(k) _Pragma("unroll 1") for (int rep_ = 0; rep_ < (((DUP_MASK) >> (k)) & 1) + 1; ++rep_)
#define SEAM(k) do { if (IN(k) && IN((k) + 1)) xcd_barrier(bar); } while (0)
    if (IN(0)) REP(0) { phase_prologue(lds, A); __syncthreads(); }
    SEAM(0);
    if (IN(1)) REP(1) {
        pg8::Gemm g{(const bf16_t*)(dob + DO_U), (const bf16_t*)(dob + DO_WIN), MP, NA, DM, 0}; pg8::StaticOrder S; S.init(MP, NA, G, bx);
        EpiA E{A.ws, (const float*)(dob + DO_CS)};
        pg8::gemm_phase<EpiA, true>(lds, g, S, E);
    }
    SEAM(1);
    if (IN(2)) REP(2) {
        for (int u = bx; u < 2 * NB * AG * (NCH - 1); u += G) { const int half = u & 1, v = u >> 1, n = 1 + v % (NCH - 1), bg = v / (NCH - 1); attn_unit(lds, A, bg >> 1, bg & 1, n, half); }
        for (int u = bx; u < NB * NCH * RH; u += G) { const int h = u & 3, bn = u >> 2; ret_kv_unit(lds, A, bn / NCH, bn % NCH, h); }
    }
    SEAM(2);
    if (IN(3)) REP(3) phase_scan(A);
    SEAM(3);
    if (IN(4)) REP(4) {
        for (int u = bx; u < NB * (NCH - 1) * RH; u += G) { const int h = u & 3, bn = u >> 2; ret_out_unit(lds, A, bn / (NCH - 1), 1 + bn % (NCH - 1), h); }
    }
    SEAM(4);
    if (IN(5)) REP(5) {
        pg8::Gemm g{(const bf16_t*)(dob + DO_U), (const bf16_t*)(dob + DO_WIN) + (size_t)NA * DM, MS, NGATE, DM, 1}; pg8::StaticOrder S; S.init(MS, NGATE, G, bx);
        EpiGate E{A.ws, A.dry};
        pg8::gemm_phase<EpiGate, true>(lds, g, S, E);
    }
    SEAM(5);
    if (IN(6)) REP(6) {
        pg8::Gemm g{(const bf16_t*)(A.ws + OFF_OR), (const bf16_t*)(dob + DO_WRB), MS, DM, DM, 0}; pg8::StaticOrder S; S.init(MS, DM, G, bx);
        EpiPost<0> E{A.ws};
        pg8::gemm_phase<EpiPost<0>, false>(lds, g, S, E);
    }
    if (IN(6) && IN(7)) __syncthreads();
    if (IN(7)) REP(7) {
        pg8::Gemm g{(const bf16_t*)(A.ws + OFF_OA), (const bf16_t*)(dob + DO_WAB), MS, DM, DM, 0}; pg8::StaticOrder S; S.init(MS, DM, G, bx);
        EpiPost<1> E{A.ws};
        pg8::gemm_phase<EpiPost<1>, false>(lds, g, S, E);
    }
    SEAM(7);
    if (IN(8)) REP(8) {
        pg8::Gemm g{(const bf16_t*)(A.ws + OFF_MIX), (const bf16_t*)(dob + DO_WO), MS, DM, DM, 0}; pg8::StaticOrder S; S.init(MS, DM, G, bx);
        EpiPost<2> E{A.ws};
        pg8::gemm_phase<EpiPost<2>, false>(lds, g, S, E);
    }
    SEAM(8);
    if (IN(9)) REP(9) phase_final(A);
#undef IN
#undef SEAM
}

extern "C" void kernel_launch(void* const* d_in, const int* in_sizes, int n_in, void* d_out, int out_size, void* d_ws, size_t ws_size, hipStream_t stream) {
    static int grid = 0;
    if (grid == 0) {
        if (n_in != 12 || out_size != MS * DM || ws_size < OFF_CTL + CTL_BYTES) { fprintf(stderr, "kernel_launch: unexpected shapes (n_in %d out %d ws %zu)\n", n_in, out_size, ws_size); grid = -1; return; }
        int dev = 0, cus = 0, per_cu = 0;
        hipGetDevice(&dev); hipDeviceGetAttribute(&cus, hipDeviceAttributeMultiprocessorCount, dev);
        if (hipFuncSetAttribute((const void*)fwd_kernel, hipFuncAttributeMaxDynamicSharedMemorySize, LDS_BYTES) != hipSuccess) { fprintf(stderr, "kernel_launch: hipFuncSetAttribute failed\n"); grid = -1; return; }
        hipOccupancyMaxActiveBlocksPerMultiprocessor(&per_cu, (const void*)fwd_kernel, 512, LDS_BYTES);
        (void)hipGetLastError();
        if (per_cu < 1) { fprintf(stderr, "kernel_launch: occupancy query says %d blocks per CU\n", per_cu); per_cu = 1; }
        grid = cus;
    }
    if (grid < 0) return;
    Args a{};
    a.x = (const float*)d_in[0]; a.meta = (const float*)d_in[1]; a.pre_w = (const float*)d_in[2]; a.w_in = (const float*)d_in[3];
    a.dec_f = (const float*)d_in[4]; a.dec_b = (const float*)d_in[5]; a.ret_nw = (const float*)d_in[6]; a.w_rb = (const float*)d_in[7];
    a.sink = (const float*)d_in[8]; a.w_ab = (const float*)d_in[9]; a.w_o = (const float*)d_in[10]; a.post_w = (const float*)d_in[11];
    a.out = (float*)d_out; a.ws = (unsigned char*)d_ws;
#if MK_N_LAUNCHES == 1
    if (hipMemsetAsync((char*)d_ws + OFF_CTL, 0, CTL_BYTES, stream) != hipSuccess) { fprintf(stderr, "kernel_launch: memset failed\n"); return; }
    a.ph_lo = 0; a.ph_hi = NPHASE;
    void* args[] = {&a};
    hipError_t e = hipLaunchCooperativeKernel((const void*)fwd_kernel, dim3(grid), dim3(512), args, LDS_BYTES, stream);
    if (e != hipSuccess) fprintf(stderr, "cooperative launch failed: %s (grid %d)\n", hipGetErrorString(e), grid);
#else
    for (int p = 0; p < NPHASE; ++p) {
        if (p == 7) continue;
        a.ph_lo = p; a.ph_hi = (p == 6) ? 8 : p + 1;
        for (int rep = 0; rep < ((HDUP_MASK >> p) & 1) + 1; ++rep) { a.dry = (rep == 0 && ((HDUP_MASK >> p) & 1)) ? 1 : 0;
        hipLaunchKernelGGL(fwd_kernel, dim3(grid), dim3(512), LDS_BYTES, stream, a); }
    }
#endif
}
```

```cpp
#include <hip/hip_runtime.h>
#include <hip/hip_cooperative_groups.h>
#include <cstdio>
#include <cstdint>
namespace cg = cooperative_groups;

#ifndef HDUP_MASK
#define HDUP_MASK 0x0
#endif
#ifndef MK_N_LAUNCHES
#define MK_N_LAUNCHES 1
#endif

#define LAS __attribute__((address_space(3)))
#define DI __device__ __forceinline__
typedef unsigned short bf16_t;
typedef short bf16x8 __attribute__((ext_vector_type(8)));
typedef float f32x4 __attribute__((ext_vector_type(4)));
typedef float f32x2 __attribute__((ext_vector_type(2)));
typedef unsigned u32x4 __attribute__((ext_vector_type(4)));
typedef unsigned u32x2 __attribute__((ext_vector_type(2)));

constexpr int DM = 1024, NB = 2, SEQ = 8192, NMETA = 16, TT = SEQ + NMETA;
constexpr int CH = 128, MPAD = CH - NMETA;
constexpr int LP = TT + MPAD;
constexpr int NCH = LP / CH;
constexpr int MP = NB * LP;
constexpr int MS = NB * SEQ;
constexpr int RH = 4, RDK = 128, RDV = 256, AH = 8, AG = 2, AHD = 128;
constexpr int DIN = 7680, NA = 3584, NGATE = 4096;
constexpr float EPSF = 1e-6f;
constexpr float LOG2E = 1.4426950408889634f;

constexpr size_t OFF_RQ = 0;
constexpr size_t OFF_RK = OFF_RQ + (size_t)MP * 512 * 2;
constexpr size_t OFF_RV = OFF_RK + (size_t)MP * 512 * 2;
constexpr size_t OFF_AQ = OFF_RV + (size_t)MP * 1024 * 2;
constexpr size_t OFF_AK = OFF_AQ + (size_t)MP * 1024 * 2;
constexpr size_t OFF_AV = OFF_AK + (size_t)MP * 256 * 2;
constexpr size_t OFF_KVS = OFF_AV + (size_t)MP * 256 * 2;
constexpr size_t KVS_BYTES = (size_t)2 * NB * NCH * RH * 32768 * 2;
constexpr size_t OFF_OR = OFF_KVS + KVS_BYTES;
constexpr size_t OFF_OA = OFF_OR + (size_t)MS * 1024 * 2;
constexpr size_t WS_END = OFF_OA + (size_t)MS * 1024 * 2;
constexpr size_t OFF_SGR = OFF_RQ, OFF_SGA = OFF_RQ + (size_t)MS * 1024 * 2;
constexpr size_t OFF_MIX = OFF_AQ;
constexpr size_t OFF_PART = OFF_KVS;
constexpr size_t OFF_OUT = OFF_OR;
static_assert(OFF_SGA + (size_t)MS * 1024 * 2 <= OFF_AQ, "gate overlay");
static_assert((size_t)MS * 1024 * 4 <= KVS_BYTES, "part overlay");
constexpr size_t OFF_CTL = WS_END;
constexpr size_t CTL_BYTES = 16384;
static_assert(OFF_CTL + CTL_BYTES <= 268435456ull, "ws");
constexpr size_t DO_U = 0;
constexpr size_t DO_WIN = DO_U + (size_t)MP * 1024 * 2;
constexpr size_t DO_WRB = DO_WIN + (size_t)DIN * 1024 * 2;
constexpr size_t DO_WAB = DO_WRB + (size_t)1024 * 1024 * 2;
constexpr size_t DO_WO = DO_WAB + (size_t)1024 * 1024 * 2;
constexpr size_t DO_CS = DO_WO + (size_t)1024 * 1024 * 2;
static_assert(DO_CS + (size_t)TT * 64 * 8 <= (size_t)MS * 1024 * 4, "d_out scratch");

constexpr int LDS_BYTES = 147456;
constexpr int LDT = 136;

typedef __bf16 bf16v2 __attribute__((ext_vector_type(2)));
DI unsigned cvt_pk_bf16(float lo, float hi) { const f32x2 v = {lo, hi}; const bf16v2 b = __builtin_convertvector(v, bf16v2); return __builtin_bit_cast(unsigned, b); }
DI float bf2f(unsigned short b) { return __uint_as_float(((unsigned)b) << 16); }
DI float bflo(unsigned w) { return __uint_as_float(w << 16); }
DI float bfhi(unsigned w) { return __uint_as_float(w & 0xffff0000u); }
DI float wave_sum(float v) {
#pragma unroll
    for (int o = 1; o < 64; o <<= 1) v += __shfl_xor(v, o);
    return v;
}
DI f32x4 mfma16(bf16x8 a, bf16x8 b, f32x4 c) { return __builtin_amdgcn_mfma_f32_16x16x32_bf16(a, b, c, 0, 0, 0); }
#define LDS_WAIT() asm volatile("s_waitcnt lgkmcnt(0)" ::: "memory")

namespace pg8 {
constexpr int BM = 256, BK = 64, HALF = 128, HTB = HALF * BK * 2, STAGE_BYTES = 8 * HTB, NXCD = 8, WGM = 8;
DI int lds_byte(int r, int c) { const int st = (r >> 4) * 2 + (c >> 5), rr = r & 15, cc = c & 31, ob = rr * 64 + cc * 2; return st * 1024 + (ob ^ (((ob >> 9) & 1) << 5)); }
DI void stage_rc(int b, int& R, int& C) { const int st = b / 1024, sb = b % 1024, swz = sb ^ (((sb >> 9) & 1) << 5); R = (st >> 1) * 16 + swz / 64; C = (st & 1) * 32 + (swz % 64) / 2; }
struct Unit { int pm, pn; };
struct Gemm { const bf16_t* A; const bf16_t* Bt; int M, N, K, amode; };
DI size_t a_row0(const Gemm& g, int pm) { return g.amode ? (size_t)((pm >> 5) * LP + 128 + (pm & 31) * 256) : (size_t)pm * 256; }
struct StaticOrder {
    int nM, nN, nwg, G, c;
    DI void init(int M, int N, int G_, int c_) { nM = M / BM; nN = N / BM; nwg = nM * nN; G = G_; c = c_; }
    DI bool next(int i, Unit& u) const {
        const long L = (long)i * G + c; if (L >= nwg) return false;
        int wgid = (int)L; { const int q = nwg / NXCD, r = nwg % NXCD, xcd = wgid % NXCD, off = wgid / NXCD; wgid = (xcd < r ? xcd * (q + 1) : r * (q + 1) + (xcd - r) * q) + off; }
        const int nig = WGM * nN, gid = wgid / nig, fm = gid * WGM, gsz = (nM - fm) < WGM ? (nM - fm) : WGM;
        u.pm = fm + ((wgid % nig) % gsz); u.pn = (wgid % nig) / gsz; return true;
    }
};
template <class Epi, bool ALIGN_EPI>
DI void gemm_phase(LAS unsigned char* lds, const Gemm g, const StaticOrder& S, const Epi& E) {
    const int tid = threadIdx.x, wid = __builtin_amdgcn_readfirstlane(tid >> 6), lane = tid & 63, wr = wid >> 2, wc = wid & 3, fr = lane & 15, fq = lane >> 4;
    const int K = g.K, nt = K / BK;
    unsigned voffA[2];
#pragma unroll
    for (int i = 0; i < 2; ++i) { int R, C; stage_rc(tid * 16 + i * 8192, R, C); voffA[i] = (unsigned)(R * K + C) * 2u; }
    const size_t kstep = (size_t)(BK * 2);
    const size_t hstep = (size_t)HALF * K * 2;
    const size_t tstep = 2 * hstep;
    const size_t rowb = (size_t)K * 2;
    const unsigned ldsw = (unsigned)wid * 1024u;
    const int aoff = lds_byte(wr * 64 + fr, fq * 8), boff = lds_byte(wc * 32 + fr, fq * 8);
#define PG8_SA(b, h) (((b) * 2 + (h)) * HTB)
#define PG8_SB(b, h) ((4 + (b) * 2 + (h)) * HTB)
#define PG8_STAGE(bufoff, gbase, voff) do { _Pragma("unroll") for (int _i = 0; _i < 2; ++_i) \
        __builtin_amdgcn_global_load_lds((const unsigned*)((const char*)(gbase) + (voff)[_i]), (LAS unsigned*)(lds + (bufoff) + ldsw + _i * 8192), 16, 0, 0); } while (0)
#define PG8_LDA(dst, b, h) do { _Pragma("unroll") for (int m = 0; m < 4; ++m) _Pragma("unroll") for (int k = 0; k < 2; ++k) dst[m][k] = *(const LAS bf16x8*)(lds + PG8_SA(b, h) + aoff + m * 2048 + k * 1024); } while (0)
#define PG8_LDB(dst, b, h) do { _Pragma("unroll") for (int n = 0; n < 2; ++n) _Pragma("unroll") for (int k = 0; k < 2; ++k) dst[n][k] = *(const LAS bf16x8*)(lds + PG8_SB(b, h) + boff + n * 2048 + k * 1024); } while (0)
#define PG8_MMA(ai, bj, At, Bt) do { __builtin_amdgcn_s_setprio(1); _Pragma("unroll") for (int m = 0; m < 4; ++m) _Pragma("unroll") for (int n = 0; n < 2; ++n) _Pragma("unroll") for (int k = 0; k < 2; ++k) \
        acc[ai][bj][m][n] = __builtin_amdgcn_mfma_f32_16x16x32_bf16(Bt[n][k], At[m][k], acc[ai][bj][m][n], 0, 0, 0); __builtin_amdgcn_s_setprio(0); } while (0)
#define PG8_WAIT_V(n) asm volatile("s_waitcnt vmcnt(" #n ")" ::: "memory")
#define PG8_WAIT_L(n) asm volatile("s_waitcnt lgkmcnt(" #n ")" ::: "memory")
#define PG8_BAR __builtin_amdgcn_s_barrier()
#define PG8_SCHED __builtin_amdgcn_sched_barrier(0)
    Unit cur, nxt; int ui = 0;
    if (!S.next(0, cur)) return;
    f32x4 acc[2][2][4][2];
#pragma unroll
    for (int a = 0; a < 2; ++a)
#pragma unroll
        for (int b = 0; b < 2; ++b)
#pragma unroll
            for (int m = 0; m < 4; ++m)
#pragma unroll
                for (int n = 0; n < 2; ++n) acc[a][b][m][n] = (f32x4){0.f, 0.f, 0.f, 0.f};
    bf16x8 At[4][2], B0[2][2], B1[2][2];
    const char* cA = (const char*)g.A + a_row0(g, cur.pm) * rowb; const char* cB = (const char*)g.Bt + (size_t)cur.pn * tstep;
    PG8_STAGE(PG8_SB(0, 0), cB, voffA); PG8_STAGE(PG8_SB(0, 1), cB + hstep, voffA); PG8_STAGE(PG8_SA(0, 0), cA, voffA); PG8_STAGE(PG8_SA(0, 1), cA + hstep, voffA);
    if (wr == 1) PG8_BAR;
    PG8_WAIT_V(2); PG8_BAR;
    PG8_STAGE(PG8_SB(1, 0), cB + kstep, voffA); PG8_STAGE(PG8_SA(1, 0), cA + kstep, voffA); PG8_STAGE(PG8_SB(1, 1), cB + hstep + kstep, voffA);
    PG8_WAIT_V(6); PG8_BAR;
    for (;;) {
        const bool has_next = S.next(ui + 1, nxt);
        const char* nA = has_next ? (const char*)g.A + a_row0(g, nxt.pm) * rowb : cA; const char* nB = has_next ? (const char*)g.Bt + (size_t)nxt.pn * tstep : cB;
        for (int t = 0; t < nt; t += 2) {
            const bool last = (t == nt - 2);
            const char* a1 = cA + (size_t)(t + 1) * kstep;
            const char* a2 = last ? nA : cA + (size_t)(t + 2) * kstep; const char* b2 = last ? nB : cB + (size_t)(t + 2) * kstep;
            const char* a3 = a2 + kstep; const char* b3 = b2 + kstep;
            PG8_LDB(B0, 0, 0); PG8_LDB(B1, 0, 1); PG8_SCHED; PG8_LDA(At, 0, 0); PG8_STAGE(PG8_SA(1, 1), a1 + hstep, voffA);
            PG8_WAIT_V(8); PG8_WAIT_L(0); PG8_BAR; PG8_MMA(0, 0, At, B0); PG8_MMA(0, 1, At, B1); PG8_BAR; PG8_SCHED;
            PG8_LDA(At, 0, 1); PG8_STAGE(PG8_SB(0, 0), b2, voffA); PG8_STAGE(PG8_SB(0, 1), b2 + hstep, voffA); PG8_STAGE(PG8_SA(0, 0), a2, voffA);
            PG8_WAIT_V(8); PG8_WAIT_L(0); PG8_BAR; PG8_MMA(1, 0, At, B0); PG8_MMA(1, 1, At, B1); PG8_BAR; PG8_SCHED;
            PG8_LDB(B0, 1, 0); PG8_LDB(B1, 1, 1); PG8_SCHED; PG8_LDA(At, 1, 0); PG8_STAGE(PG8_SA(0, 1), a2 + hstep, voffA);
            PG8_WAIT_V(8); PG8_WAIT_L(0); PG8_BAR; PG8_MMA(0, 0, At, B0); PG8_MMA(0, 1, At, B1); PG8_BAR; PG8_SCHED;
            PG8_LDA(At, 1, 1); PG8_STAGE(PG8_SB(1, 0), b3, voffA); PG8_STAGE(PG8_SB(1, 1), b3 + hstep, voffA); PG8_STAGE(PG8_SA(1, 0), a3, voffA);
            PG8_WAIT_V(8); PG8_WAIT_L(0); PG8_BAR; PG8_MMA(1, 0, At, B0); PG8_MMA(1, 1, At, B1); PG8_BAR; PG8_SCHED;
        }
        if constexpr (ALIGN_EPI) { if (wr == 0) PG8_BAR; }
        E(acc, cur, wr, wc, fr, fq);
        if (!has_next) break;
#pragma unroll
        for (int a = 0; a < 2; ++a)
#pragma unroll
            for (int b = 0; b < 2; ++b)
#pragma unroll
                for (int m = 0; m < 4; ++m)
#pragma unroll
                    for (int n = 0; n < 2; ++n) acc[a][b][m][n] = (f32x4){0.f, 0.f, 0.f, 0.f};
        cur = nxt; cA = nA; cB = nB; ++ui;
        if constexpr (ALIGN_EPI) { if (wr == 1) PG8_BAR; }
    }
    PG8_WAIT_V(0);
    if constexpr (!ALIGN_EPI) { if (wr == 0) PG8_BAR; }
    PG8_BAR;
#undef PG8_SA
#undef PG8_SB
#undef PG8_STAGE
#undef PG8_LDA
#undef PG8_LDB
#undef PG8_MMA
#undef PG8_WAIT_V
#undef PG8_WAIT_L
#undef PG8_BAR
#undef PG8_SCHED
}
}

typedef f32x4 Acc[2][2][4][2];
struct EpiA {
    unsigned char* ws; const float* cs;
    DI void operator()(const Acc& acc, const pg8::Unit& u, int wr, int wc, int fr, int fq) const {
        const int pn = u.pn; size_t off; int ld, colb, rot; float sc;
        if (pn < 2) { off = OFF_RQ; ld = 512; colb = pn * 256; rot = 1; sc = 1.f; }
        else if (pn < 4) { off = OFF_RK; ld = 512; colb = (pn - 2) * 256; rot = 1; sc = 0.08838834764831845f; }
        else if (pn < 8) { off = OFF_RV; ld = 1024; colb = (pn - 4) * 256; rot = 0; sc = 1.f; }
        else if (pn < 12) { off = OFF_AQ; ld = 1024; colb = (pn - 8) * 256; rot = 1; sc = 0.08838834764831845f * LOG2E; }
        else if (pn == 12) { off = OFF_AK; ld = 256; colb = 0; rot = 1; sc = 1.f; }
        else { off = OFF_AV; ld = 256; colb = 0; rot = 0; sc = 1.f; }
        bf16_t* dst = (bf16_t*)(ws + off);
#pragma unroll
        for (int ai = 0; ai < 2; ++ai)
#pragma unroll
            for (int m = 0; m < 4; ++m) {
                const int r = u.pm * 256 + ai * 128 + wr * 64 + m * 16 + fr;
                const int p = r >= LP ? r - LP : r; const int t = p >= MPAD ? p - MPAD : 0;
                f32x4 c4 = (f32x4){sc, sc, sc, sc}, s4 = (f32x4){0.f, 0.f, 0.f, 0.f};
                if (rot) { const f32x4* pc = (const f32x4*)(cs + ((size_t)t * 64 + 16 * wc + 4 * fq) * 2); const f32x4 x0 = pc[0], x1 = pc[1];
                    c4 = (f32x4){x0[0], x0[2], x1[0], x1[2]} * sc; s4 = (f32x4){x0[1], x0[3], x1[1], x1[3]} * sc; }
                bf16_t* rowp = dst + (size_t)r * ld + colb + 16 * wc + 4 * fq;
#pragma unroll
                for (int bj = 0; bj < 2; ++bj) {
                    const f32x4 v0 = acc[ai][bj][m][0], v1 = acc[ai][bj][m][1];
                    const f32x4 o0 = v0 * c4 - v1 * s4, o1 = v1 * c4 + v0 * s4;
                    u32x2 w0, w1; w0.x = cvt_pk_bf16(o0[0], o0[1]); w0.y = cvt_pk_bf16(o0[2], o0[3]); w1.x = cvt_pk_bf16(o1[0], o1[1]); w1.y = cvt_pk_bf16(o1[2], o1[3]);
                    *(u32x2*)(rowp + bj * 128) = w0; *(u32x2*)(rowp + bj * 128 + 64) = w1;
                }
            }
    }
};
DI float sigmoidf_(float x) { return __builtin_amdgcn_rcpf(1.f + __expf(-x)); }
struct EpiGate {
    unsigned char* ws; int dry;
    DI void operator()(const Acc& acc, const pg8::Unit& u, int wr, int wc, int fr, int fq) const {
        const int seg = u.pn >> 2, colb = (u.pn & 3) * 256;
        bf16_t* dst = (bf16_t*)(ws + (seg == 0 ? OFF_OR : seg == 1 ? OFF_OA : seg == 2 ? OFF_SGR : OFF_SGA));
#pragma unroll
        for (int ai = 0; ai < 2; ++ai)
#pragma unroll
            for (int m = 0; m < 4; ++m) {
                const int r = u.pm * 256 + ai * 128 + wr * 64 + m * 16 + fr;
#pragma unroll
                for (int bj = 0; bj < 2; ++bj)
#pragma unroll
                    for (int n = 0; n < 2; ++n) {
                        bf16_t* p = dst + (size_t)r * 1024 + colb + bj * 128 + wc * 32 + n * 16 + 4 * fq;
                        const f32x4 a = acc[ai][bj][m][n]; f32x4 o;
#pragma unroll
                        for (int e = 0; e < 4; ++e) o[e] = sigmoidf_(a[e]);
                        if (seg < 2) { const u32x2 w = *(const u32x2*)p; o = o * a; if (dry) o = (f32x4){1.f, 1.f, 1.f, 1.f}; o[0] *= bflo(w.x); o[1] *= bfhi(w.x); o[2] *= bflo(w.y); o[3] *= bfhi(w.y); }
                        u32x2 w2; w2.x = cvt_pk_bf16(o[0], o[1]); w2.y = cvt_pk_bf16(o[2], o[3]); *(u32x2*)p = w2;
                    }
            }
    }
};
template <int MODE> struct EpiPost {
    unsigned char* ws;
    DI void operator()(const Acc& acc, const pg8::Unit& u, int wr, int wc, int fr, int fq) const {
#pragma unroll
        for (int ai = 0; ai < 2; ++ai)
#pragma unroll
            for (int m = 0; m < 4; ++m) {
                const int r = u.pm * 256 + ai * 128 + wr * 64 + m * 16 + fr;
#pragma unroll
                for (int bj = 0; bj < 2; ++bj)
#pragma unroll
                    for (int n = 0; n < 2; ++n) {
                        const size_t idx = (size_t)r * 1024 + u.pn * 256 + bj * 128 + wc * 32 + n * 16 + 4 * fq;
                        const f32x4 a = acc[ai][bj][m][n];
                        if (MODE == 2) { *(f32x4*)((float*)(ws + OFF_OUT) + idx) = a; }
                        else {
                            const u32x2 w = *(const u32x2*)((const bf16_t*)(ws + (MODE == 0 ? OFF_SGR : OFF_SGA)) + idx);
                            f32x4 o = (f32x4){a[0] * bflo(w.x), a[1] * bfhi(w.x), a[2] * bflo(w.y), a[3] * bfhi(w.y)};
                            if (MODE == 0) { *(f32x4*)((float*)(ws + OFF_PART) + idx) = o; }
                            else { o = o + *(const f32x4*)((const float*)(ws + OFF_PART) + idx);
                                u32x2 w2; w2.x = cvt_pk_bf16(o[0], o[1]); w2.y = cvt_pk_bf16(o[2], o[3]); *(u32x2*)((bf16_t*)(ws + OFF_MIX) + idx) = w2; }
                        }
                    }
            }
    }
};

struct Args {
    const float* x; const float* meta; const float* pre_w; const float* w_in; const float* dec_f; const float* dec_b; const float* ret_nw;
    const float* w_rb; const float* sink; const float* w_ab; const float* w_o; const float* post_w;
    float* out; unsigned char* ws; int ph_lo, ph_hi, dry, pad_;
};

DI int win_dst_row(int c) {
    int d;
    if (c < 2048) d = c; else if (c < 3072) d = 3584 + (c - 2048); else if (c < 4608) d = 2048 + (c - 3072); else d = c;
    if (d < NA) { const int q = d & 127; d = (d & ~127) + 32 * ((q >> 4) & 3) + 16 * (q >> 6) + (q & 15); }
    return d;
}
template <bool WIN>
DI void p0_transpose_item(const float* W, int K, int N, bf16_t* WT, LAS float* scr, int item, int lane) {
    const int nblk = N / 32, kb = item / nblk, nb = item % nblk, k0 = 64 * kb, n0 = 32 * nb;
#pragma unroll 8
    for (int i = 0; i < 32; ++i) { const int kk = 2 * i + (lane >> 5); scr[kk * 33 + (lane & 31)] = W[(size_t)(k0 + kk) * N + n0 + (lane & 31)]; }
    LDS_WAIT();
    const int c = lane & 7;
#pragma unroll
    for (int j = 0; j < 4; ++j) { const int n = (lane >> 3) + 8 * j; const LAS float* s = scr + (8 * c) * 33 + n;
        u32x4 o; o.x = cvt_pk_bf16(s[0 * 33], s[1 * 33]); o.y = cvt_pk_bf16(s[2 * 33], s[3 * 33]); o.z = cvt_pk_bf16(s[4 * 33], s[5 * 33]); o.w = cvt_pk_bf16(s[6 * 33], s[7 * 33]);
        const int drow = WIN ? win_dst_row(n0 + n) : (n0 + n);
        *(u32x4*)(WT + (size_t)drow * K + k0 + 8 * c) = o; }
    LDS_WAIT();
}
DI void phase_prologue(LAS unsigned char* lds, const Args& A) {
    const int tid = threadIdx.x, lane = tid & 63, wave = tid >> 6;
    const int gw = blockIdx.x * 8 + wave, NGW = gridDim.x * 8;
    unsigned char* dob = (unsigned char*)A.out;
    LAS float* scr = (LAS float*)(lds + wave * 16384);
    constexpr int I_IN = (DM / 64) * (DIN / 32), I_SQ = (DM / 64) * (DM / 32);
    for (int it = gw; it < I_IN + 3 * I_SQ; it += NGW) {
        int r = it;
        if (r < I_IN) { p0_transpose_item<true>(A.w_in, DM, DIN, (bf16_t*)(dob + DO_WIN), scr, r, lane); continue; } r -= I_IN;
        if (r < I_SQ) { p0_transpose_item<false>(A.w_rb, DM, DM, (bf16_t*)(dob + DO_WRB), scr, r, lane); continue; } r -= I_SQ;
        if (r < I_SQ) { p0_transpose_item<false>(A.w_ab, DM, DM, (bf16_t*)(dob + DO_WAB), scr, r, lane); continue; } r -= I_SQ;
        p0_transpose_item<false>(A.w_o, DM, DM, (bf16_t*)(dob + DO_WO), scr, r, lane);
    }
    bf16_t* U = (bf16_t*)(dob + DO_U);
    for (int r = gw; r < MP; r += NGW) {
        const int b = r >= LP ? 1 : 0, p = r - b * LP;
        u32x2* o8 = (u32x2*)(U + (size_t)r * DM) + lane;
        if (p < MPAD) {
#pragma unroll
            for (int j = 0; j < 4; ++j) o8[64 * j] = (u32x2){0u, 0u};
            continue; }
        const int t = p - MPAD;
        const float* src = t < NMETA ? A.meta + (size_t)t * DM : A.x + ((size_t)b * SEQ + (t - NMETA)) * DM;
        const f32x4* xr = (const f32x4*)src + lane; const f32x4* wr4 = (const f32x4*)A.pre_w + lane;
        f32x4 v[4]; float s = 0.f;
#pragma unroll
        for (int j = 0; j < 4; ++j) { v[j] = xr[64 * j]; s += (v[j][0] * v[j][0] + v[j][1] * v[j][1]) + (v[j][2] * v[j][2] + v[j][3] * v[j][3]); }
        const float rs = rsqrtf(wave_sum(s) * (1.f / DM) + EPSF);
#pragma unroll
        for (int j = 0; j < 4; ++j) { const f32x4 w = wr4[64 * j]; const f32x4 y = v[j] * rs * w; o8[64 * j] = (u32x2){cvt_pk_bf16(y[0], y[1]), cvt_pk_bf16(y[2], y[3])}; }
    }
    float* cs = (float*)(dob + DO_CS);
    for (int i = blockIdx.x * 512 + tid; i < TT * 64; i += gridDim.x * 512) {
        const int t = i >> 6, f = i & 63;
        const float inv = (float)exp2(-(double)f * (2.0 / 128.0) * 13.287712379549449);
        const float ang = (float)t * inv;
        double rev = (double)ang * 0.15915494309189535; rev -= floor(rev);
        const float fr = (float)rev;
        cs[2 * i] = __builtin_amdgcn_cosf(fr); cs[2 * i + 1] = __builtin_amdgcn_sinf(fr);
    }
}

template <int ROWS> DI void stage_plain(LAS bf16_t* dst, const bf16_t* src, int ld, int tid) {
#pragma unroll
    for (int i = 0; i < ROWS / 32; ++i) { const int id = tid + 512 * i, row = id >> 4, c8 = id & 15;
        const u32x4 v = *(const u32x4*)(src + (size_t)row * ld + c8 * 8); *(LAS u32x4*)(dst + row * LDT + c8 * 8) = v; }
}
template <int NCOLS> DI void stage_transposed(LAS bf16_t* dst, const bf16_t* src, int ld, int tid) {
    const int j = tid & 127;
#pragma unroll
    for (int i = 0; i < NCOLS / 32; ++i) { const int g8 = (tid >> 7) + 4 * i;
        const u32x4 v = *(const u32x4*)(src + (size_t)j * ld + g8 * 8);
        LAS bf16_t* d = dst + (g8 * 8) * LDT + j;
        d[0 * LDT] = (bf16_t)(v.x & 0xffff); d[1 * LDT] = (bf16_t)(v.x >> 16); d[2 * LDT] = (bf16_t)(v.y & 0xffff); d[3 * LDT] = (bf16_t)(v.y >> 16);
        d[4 * LDT] = (bf16_t)(v.z & 0xffff); d[5 * LDT] = (bf16_t)(v.z >> 16); d[6 * LDT] = (bf16_t)(v.w & 0xffff); d[7 * LDT] = (bf16_t)(v.w >> 16); }
}
typedef short s16x4 __attribute__((ext_vector_type(4)));
DI int tr_lane_off(int ld, int lane) { return (8 * (lane >> 4) + ((lane & 15) >> 2)) * ld + 4 * (lane & 3); }
DI bf16x8 tr_frag(const LAS bf16_t* p, int ld) {
    const s16x4 lo = __builtin_amdgcn_ds_read_tr16_b64_v4i16((LAS s16x4*)p);
    const s16x4 hi = __builtin_amdgcn_ds_read_tr16_b64_v4i16((LAS s16x4*)(p + 4 * ld));
    return __builtin_shufflevector(lo, hi, 0, 1, 2, 3, 4, 5, 6, 7);
}
constexpr int VLD = 264;
template <int ROWS> DI void stage_plain256(LAS bf16_t* dst, const bf16_t* src, int ld, int tid) {
#pragma unroll
    for (int i = 0; i < ROWS / 16; ++i) { const int id = tid + 512 * i, row = id >> 5, c8 = id & 31;
        const u32x4 v = *(const u32x4*)(src + (size_t)row * ld + c8 * 8); *(LAS u32x4*)(dst + row * VLD + c8 * 8) = v; }
}
DI bf16x8 scale_frag(bf16x8 a, float s) {
    const u32x4 w = __builtin_bit_cast(u32x4, a); u32x4 o;
    o.x = cvt_pk_bf16(bflo(w.x) * s, bfhi(w.x) * s); o.y = cvt_pk_bf16(bflo(w.y) * s, bfhi(w.y) * s);
    o.z = cvt_pk_bf16(bflo(w.z) * s, bfhi(w.z) * s); o.w = cvt_pk_bf16(bflo(w.w) * s, bfhi(w.w) * s);
    return __builtin_bit_cast(bf16x8, o);
}
DI float log2_sigmoid(float d) { return -log2f(1.f + expf(-d)); }
DI size_t kvs_off(int dir, int b, int n, int h) { return ((((size_t)dir * NB + b) * NCH + n) * RH + h) * 32768; }

DI void ret_kv_unit(LAS unsigned char* lds, const Args& A, int b, int n, int h) {
    const int tid = threadIdx.x, lane = tid & 63, w = tid >> 6, fr = lane & 15, fq = lane >> 4;
    LAS bf16_t* Vr = (LAS bf16_t*)lds;
    LAS bf16_t* Kf = Vr + 128 * VLD;
    LAS bf16_t* Kb = Kf + 128 * LDT;
    const float lgf = log2_sigmoid(A.dec_f[h]), lgb = log2_sigmoid(A.dec_b[h]);
    const size_t row0 = (size_t)b * LP + (size_t)n * CH;
    const bf16_t* RK = (const bf16_t*)(A.ws + OFF_RK) + row0 * 512 + h * 128;
    const bf16_t* RV = (const bf16_t*)(A.ws + OFF_RV) + row0 * 1024 + h * 256;
    stage_plain256<128>(Vr, RV, 1024, tid);
#pragma unroll
    for (int i = 0; i < 4; ++i) { const int id = tid + 512 * i, j = id >> 4, c8 = id & 15;
        const float wf = exp2f((float)(127 - j) * lgf), wb = exp2f((float)j * lgb);
        const u32x4 v = *(const u32x4*)(RK + (size_t)j * 512 + c8 * 8);
        const float f[8] = {bflo(v.x), bfhi(v.x), bflo(v.y), bfhi(v.y), bflo(v.z), bfhi(v.z), bflo(v.w), bfhi(v.w)};
        u32x4 of, ob;
        of.x = cvt_pk_bf16(f[0] * wf, f[1] * wf); of.y = cvt_pk_bf16(f[2] * wf, f[3] * wf); of.z = cvt_pk_bf16(f[4] * wf, f[5] * wf); of.w = cvt_pk_bf16(f[6] * wf, f[7] * wf);
        ob.x = cvt_pk_bf16(f[0] * wb, f[1] * wb); ob.y = cvt_pk_bf16(f[2] * wb, f[3] * wb); ob.z = cvt_pk_bf16(f[4] * wb, f[5] * wb); ob.w = cvt_pk_bf16(f[6] * wb, f[7] * wb);
        *(LAS u32x4*)(Kf + j * LDT + c8 * 8) = of; *(LAS u32x4*)(Kb + j * LDT + c8 * 8) = ob; }
    __syncthreads();
    const int trV = tr_lane_off(VLD, lane), trK = tr_lane_off(LDT, lane);
#pragma unroll 1
    for (int dir = 0; dir < 2; ++dir) {
        const LAS bf16_t* Kx = dir ? Kb : Kf;
        f32x4 aF[2][8];
#pragma unroll
        for (int mt = 0; mt < 2; ++mt)
#pragma unroll
            for (int nt = 0; nt < 8; ++nt) aF[mt][nt] = (f32x4){0.f, 0.f, 0.f, 0.f};
#pragma unroll
        for (int ks = 0; ks < 4; ++ks) {
            bf16x8 a[2];
#pragma unroll
            for (int mt = 0; mt < 2; ++mt) a[mt] = tr_frag(Vr + trV + (32 * ks) * VLD + 32 * w + 16 * mt, VLD);
#pragma unroll
            for (int nt = 0; nt < 8; ++nt) {
                const bf16x8 bf = tr_frag(Kx + trK + (32 * ks) * LDT + 16 * nt, LDT);
#pragma unroll
                for (int mt = 0; mt < 2; ++mt) aF[mt][nt] = mfma16(bf, a[mt], aF[mt][nt]);
            }
        }
        bf16_t* of = (bf16_t*)(A.ws + OFF_KVS) + kvs_off(dir, b, n, h);
#pragma unroll
        for (int mt = 0; mt < 2; ++mt)
#pragma unroll
            for (int nt = 0; nt < 8; ++nt) { const int o = (32 * w + 16 * mt + fr) * 128 + 16 * nt + 4 * fq;
                *(u32x2*)(of + o) = (u32x2){cvt_pk_bf16(aF[mt][nt][0], aF[mt][nt][1]), cvt_pk_bf16(aF[mt][nt][2], aF[mt][nt][3])}; }
    }
    __syncthreads();
}

DI void phase_scan(const Args& A) {
    bf16_t* KVS = (bf16_t*)(A.ws + OFF_KVS);
    for (int idx = blockIdx.x * 512 + threadIdx.x; idx < 2 * NB * RH * 8192; idx += gridDim.x * 512) {
        const int e4 = idx & 8191, h = (idx >> 13) & 3, b = (idx >> 15) & 1, dir = idx >> 16;
        const float lg = log2_sigmoid(dir ? A.dec_b[h] : A.dec_f[h]); const float cd = exp2f(128.f * lg);
        f32x4 S = (f32x4){0.f, 0.f, 0.f, 0.f};
#pragma unroll 1
        for (int g = 0; g < 5; ++g) {
            u32x2 v[13];
#pragma unroll
            for (int k = 0; k < 13; ++k) { const int s = g * 13 + k, n = dir ? (NCH - 1 - s) : s; v[k] = *(const u32x2*)(KVS + kvs_off(dir, b, n, h) + (size_t)e4 * 4); }
#pragma unroll
            for (int k = 0; k < 13; ++k) { const int s = g * 13 + k, n = dir ? (NCH - 1 - s) : s;
                *(u32x2*)(KVS + kvs_off(dir, b, n, h) + (size_t)e4 * 4) = A.dry ? v[k] : (u32x2){cvt_pk_bf16(S[0], S[1]), cvt_pk_bf16(S[2], S[3])};
                S = S * cd + (f32x4){bflo(v[k].x), bfhi(v[k].x), bflo(v[k].y), bfhi(v[k].y)}; }
        }
    }
}

DI void ret_out_unit(LAS unsigned char* lds, const Args& A, int b, int n, int h) {
    const int tid = threadIdx.x, lane = tid & 63, w = tid >> 6, fr = lane & 15, fq = lane >> 4;
    LAS bf16_t* Kt = (LAS bf16_t*)lds;
    LAS bf16_t* Vt = Kt + 128 * LDT;
    LAS bf16_t* Pw = Vt + 256 * LDT + w * 16 * LDT;
    const float lgf = log2_sigmoid(A.dec_f[h]), lgb = log2_sigmoid(A.dec_b[h]);
    const size_t row0 = (size_t)b * LP + (size_t)n * CH;
    const int i = 16 * w + fr;
    bf16x8 q[4];
    { const bf16_t* qp = (const bf16_t*)(A.ws + OFF_RQ) + (row0 + i) * 512 + h * 128 + fq * 8;
#pragma unroll
      for (int ks = 0; ks < 4; ++ks) q[ks] = *(const bf16x8*)(qp + ks * 32); }
    stage_plain<128>(Kt, (const bf16_t*)(A.ws + OFF_RK) + row0 * 512 + h * 128, 512, tid);
    stage_plain256<128>(Vt, (const bf16_t*)(A.ws + OFF_RV) + row0 * 1024 + h * 256, 1024, tid);
    __syncthreads();
    f32x4 S[8];
#pragma unroll
    for (int nt = 0; nt < 8; ++nt) S[nt] = (f32x4){0.f, 0.f, 0.f, 0.f};
#pragma unroll
    for (int ks = 0; ks < 4; ++ks)
#pragma unroll
        for (int nt = 0; nt < 8; ++nt) S[nt] = mfma16(*(const LAS bf16x8*)(Kt + (16 * nt + fr) * LDT + ks * 32 + fq * 8), q[ks], S[nt]);
#pragma unroll
    for (int nt = 0; nt < 8; ++nt) {
#pragma unroll
        for (int e = 0; e < 4; ++e) { const int d = i - (16 * nt + 4 * fq + e); S[nt][e] *= d >= 0 ? exp2f((float)d * lgf) : exp2f((float)(-d) * lgb); }
        *(LAS u32x2*)(Pw + fr * LDT + 16 * nt + 4 * fq) = (u32x2){cvt_pk_bf16(S[nt][0], S[nt][1]), cvt_pk_bf16(S[nt][2], S[nt][3])};
    }
    LDS_WAIT();
    f32x4 O[16];
#pragma unroll
    for (int nt = 0; nt < 16; ++nt) O[nt] = (f32x4){0.f, 0.f, 0.f, 0.f};
    { const int trV = tr_lane_off(VLD, lane);
#pragma unroll
    for (int ks = 0; ks < 4; ++ks) { const bf16x8 p = *(const LAS bf16x8*)(Pw + fr * LDT + ks * 32 + fq * 8);
#pragma unroll
        for (int nt = 0; nt < 16; ++nt) O[nt] = mfma16(tr_frag(Vt + trV + (32 * ks) * VLD + 16 * nt, VLD), p, O[nt]); } }
#pragma unroll
    for (int dir = 0; dir < 2; ++dir) {
        __syncthreads();
        stage_plain<256>(Vt, (const bf16_t*)(A.ws + OFF_KVS) + kvs_off(dir, b, n, h), 128, tid);
        __syncthreads();
        const float qs = dir ? exp2f((float)(128 - i) * lgb) : exp2f((float)(i + 1) * lgf);
#pragma unroll
        for (int ks = 0; ks < 4; ++ks) { const bf16x8 p = scale_frag(q[ks], qs);
#pragma unroll
            for (int nt = 0; nt < 16; ++nt) O[nt] = mfma16(*(const LAS bf16x8*)(Vt + (16 * nt + fr) * LDT + ks * 32 + fq * 8), p, O[nt]); }
    }
    float s = 0.f;
#pragma unroll
    for (int nt = 0; nt < 16; ++nt) s += (O[nt][0] + O[nt][1]) + (O[nt][2] + O[nt][3]);
    s += __shfl_xor(s, 16); s += __shfl_xor(s, 32);
    const float mu = s * (1.f / 256.f); float q2 = 0.f;
#pragma unroll
    for (int nt = 0; nt < 16; ++nt) { const f32x4 d = O[nt] - mu; q2 += (d[0] * d[0] + d[1] * d[1]) + (d[2] * d[2] + d[3] * d[3]); }
    q2 += __shfl_xor(q2, 16); q2 += __shfl_xor(q2, 32);
    const float rstd = rsqrtf(q2 * (1.f / 256.f) + EPSF);
    bf16_t* orow = (bf16_t*)(A.ws + OFF_OR) + ((size_t)b * SEQ + (size_t)(n - 1) * CH + i) * 1024 + h * 256;
    const float* nw = A.ret_nw + h * 256;
#pragma unroll
    for (int nt = 0; nt < 16; ++nt) { const f32x4 wv = *(const f32x4*)(nw + 16 * nt + 4 * fq); const f32x4 y = (O[nt] - mu) * rstd * wv;
        *(u32x2*)(orow + 16 * nt + 4 * fq) = (u32x2){cvt_pk_bf16(y[0], y[1]), cvt_pk_bf16(y[2], y[3])}; }
    __syncthreads();
}

DI int swz(int r) { return ((r & 7) << 1) | ((r >> 3) & 1); }
DI void attn_unit(LAS unsigned char* lds, const Args& A, int b, int g, int n, int half) {
    const int tid = threadIdx.x, lane = tid & 63, w = __builtin_amdgcn_readfirstlane(tid >> 6), fr = lane & 15, fq = lane >> 4;
    const int head = g * 4 + (w >> 1), rbase = 64 * half + 32 * (w & 1);
    const float NEG = -1e30f;
    const float sinkl = A.sink[head] * LOG2E;
    f32x4 O[2][8]; float mrun[2], lrun[2];
#pragma unroll
    for (int mt = 0; mt < 2; ++mt) { mrun[mt] = sinkl; lrun[mt] = 1.f;
#pragma unroll
        for (int nt = 0; nt < 8; ++nt) O[mt][nt] = (f32x4){0.f, 0.f, 0.f, 0.f}; }
    const size_t qrow0 = (size_t)b * LP + (size_t)n * CH;
    bf16x8 q[2][4];
    { const bf16_t* AQ = (const bf16_t*)(A.ws + OFF_AQ) + (qrow0 + rbase + fr) * 1024 + head * 128 + fq * 8;
#pragma unroll
      for (int mt = 0; mt < 2; ++mt)
#pragma unroll
          for (int ks = 0; ks < 4; ++ks) q[mt][ks] = *(const bf16x8*)(AQ + (size_t)(16 * mt) * 1024 + ks * 32); }
    const unsigned vm = (n >= 2 ? 1u : 0u) | 2u | (n <= NCH - 2 ? 4u : 0u) | 8u;
    const bf16_t* AKb = (const bf16_t*)(A.ws + OFF_AK) + (size_t)b * LP * 256 + g * 128;
    const bf16_t* AVb = (const bf16_t*)(A.ws + OFF_AV) + (size_t)b * LP * 256 + g * 128;
    int dsrc[4];
#pragma unroll
    for (int i = 0; i < 4; ++i) { const int row = 4 * (8 * i + w) + (lane >> 4); dsrc[i] = row * 256 + (((lane & 15) ^ swz(row)) << 3); }
#define ATT_DMA(kt_, buf_) do { const size_t kr_ = (size_t)((kt_) == 3 ? 0 : n - 1 + (kt_)) * CH * 256; \
        _Pragma("unroll") for (int i_ = 0; i_ < 4; ++i_) { \
            __builtin_amdgcn_global_load_lds((const unsigned*)(AKb + kr_ + dsrc[i_]), (LAS unsigned*)(lds + (buf_) * 65536 + (8 * i_ + w) * 1024), 16, 0, 0); \
            __builtin_amdgcn_global_load_lds((const unsigned*)(AVb + kr_ + dsrc[i_]), (LAS unsigned*)(lds + (buf_) * 65536 + 32768 + (8 * i_ + w) * 1024), 16, 0, 0); } } while (0)
    const int koff = fr * 256;
    const int kx = swz(fr);
    const int tg = lane >> 4, tq = (lane & 15) >> 2, tp = lane & 3;
    const int vrow = 4 * tg + tq, vx = swz(vrow), voff = vrow * 256 + (tp & 1) * 8;
    int kt = __builtin_ctz(vm), buf = 0;
    ATT_DMA(kt, 0);
#pragma unroll 1
    for (;;) {
        asm volatile("s_waitcnt vmcnt(0)" ::: "memory");
        __syncthreads();
        const unsigned rest = vm >> (kt + 1);
        const int ktn = rest ? kt + 1 + __builtin_ctz(rest) : -1;
        if (ktn >= 0) ATT_DMA(ktn, buf ^ 1);
        const LAS unsigned char* Kt = lds + buf * 65536; const LAS unsigned char* Vt = Kt + 32768;
        const int ntlo = kt == 0 ? (rbase >> 4) : kt == 3 ? 7 : 0;
        const int nthi = kt == 2 ? (rbase >> 4) + 2 : 8;
        f32x4 S[2][8];
#pragma unroll
        for (int nt = 0; nt < 8; ++nt) {
            if (nt >= ntlo && nt < nthi) {
                S[0][nt] = (f32x4){0.f, 0.f, 0.f, 0.f}; S[1][nt] = (f32x4){0.f, 0.f, 0.f, 0.f};
#pragma unroll
                for (int ks = 0; ks < 4; ++ks) { const bf16x8 kf = *(const LAS bf16x8*)(Kt + nt * 4096 + koff + (((4 * ks + fq) ^ kx) << 4));
                    S[0][nt] = mfma16(kf, q[0][ks], S[0][nt]); S[1][nt] = mfma16(kf, q[1][ks], S[1][nt]); }
            } else { S[0][nt] = (f32x4){NEG, NEG, NEG, NEG}; S[1][nt] = (f32x4){NEG, NEG, NEG, NEG}; }
        }
#pragma unroll
        for (int mt = 0; mt < 2; ++mt) {
            const int ii = rbase + 16 * mt + fr;
            const int klo = (kt == 0 ? ii : kt == 3 ? MPAD : 0) - 4 * fq, khi = (kt == 2 ? ii : 127) - 4 * fq;
            float mx = NEG;
            if (kt != 1) {
#pragma unroll
                for (int nt = 0; nt < 8; ++nt)
                    if (nt >= ntlo && nt < nthi) {
#pragma unroll
                        for (int e = 0; e < 4; ++e) { const int jc = 16 * nt + e; S[mt][nt][e] = (jc >= klo && jc <= khi) ? S[mt][nt][e] : NEG; }
                    }
            }
#pragma unroll
            for (int nt = 0; nt < 8; ++nt)
                if (nt >= ntlo && nt < nthi) mx = fmaxf(fmaxf(mx, fmaxf(S[mt][nt][0], S[mt][nt][1])), fmaxf(S[mt][nt][2], S[mt][nt][3]));
            mx = fmaxf(mx, __shfl_xor(mx, 16)); mx = fmaxf(mx, __shfl_xor(mx, 32));
            const float mnew = fmaxf(mrun[mt], mx), alpha = __builtin_amdgcn_exp2f(mrun[mt] - mnew);
            float rs = 0.f;
#pragma unroll
            for (int nt = 0; nt < 8; ++nt) {
                if (nt >= ntlo && nt < nthi) {
#pragma unroll
                    for (int e = 0; e < 4; ++e) { S[mt][nt][e] = __builtin_amdgcn_exp2f(S[mt][nt][e] - mnew); rs += S[mt][nt][e]; }
                } else S[mt][nt] = (f32x4){0.f, 0.f, 0.f, 0.f};
            }
            rs += __shfl_xor(rs, 16); rs += __shfl_xor(rs, 32);
            lrun[mt] = lrun[mt] * alpha + rs; mrun[mt] = mnew;
#pragma unroll
            for (int nt = 0; nt < 8; ++nt) O[mt][nt] = O[mt][nt] * alpha;
        }
        const int kslo = ntlo >> 1, kshi = (nthi + 1) >> 1;
#pragma unroll
        for (int ks = 0; ks < 4; ++ks)
            if (ks >= kslo && ks < kshi) {
                u32x4 w0, w1;
                w0.x = cvt_pk_bf16(S[0][2 * ks][0], S[0][2 * ks][1]); w0.y = cvt_pk_bf16(S[0][2 * ks][2], S[0][2 * ks][3]);
                w0.z = cvt_pk_bf16(S[0][2 * ks + 1][0], S[0][2 * ks + 1][1]); w0.w = cvt_pk_bf16(S[0][2 * ks + 1][2], S[0][2 * ks + 1][3]);
                w1.x = cvt_pk_bf16(S[1][2 * ks][0], S[1][2 * ks][1]); w1.y = cvt_pk_bf16(S[1][2 * ks][2], S[1][2 * ks][3]);
                w1.z = cvt_pk_bf16(S[1][2 * ks + 1][0], S[1][2 * ks + 1][1]); w1.w = cvt_pk_bf16(S[1][2 * ks + 1][2], S[1][2 * ks + 1][3]);
                const bf16x8 p0 = __builtin_bit_cast(bf16x8, w0), p1 = __builtin_bit_cast(bf16x8, w1);
#pragma unroll
                for (int nt = 0; nt < 8; ++nt) {
                    const LAS unsigned char* vp = Vt + ks * 8192 + voff + (((2 * nt + (tp >> 1)) ^ vx) << 4);
                    const s16x4 lo = __builtin_amdgcn_ds_read_tr16_b64_v4i16((LAS s16x4*)vp);
                    const s16x4 hi = __builtin_amdgcn_ds_read_tr16_b64_v4i16((LAS s16x4*)(vp + 4096));
                    const bf16x8 vf = __builtin_shufflevector(lo, hi, 0, 1, 2, 3, 4, 5, 6, 7);
                    O[0][nt] = mfma16(vf, p0, O[0][nt]); O[1][nt] = mfma16(vf, p1, O[1][nt]); }
            }
        if (ktn < 0) break;
        kt = ktn; buf ^= 1;
    }
#undef ATT_DMA
    bf16_t* OA = (bf16_t*)(A.ws + OFF_OA) + ((size_t)b * SEQ + (size_t)(n - 1) * CH) * 1024 + head * 128;
#pragma unroll
    for (int mt = 0; mt < 2; ++mt) { const float inv = 1.f / lrun[mt]; const int ii = rbase + 16 * mt + fr;
#pragma unroll
        for (int nt = 0; nt < 8; ++nt) { const f32x4 y = O[mt][nt] * inv;
            *(u32x2*)(OA + (size_t)ii * 1024 + 16 * nt + 4 * fq) = (u32x2){cvt_pk_bf16(y[0], y[1]), cvt_pk_bf16(y[2], y[3])}; } }
    __syncthreads();
}

DI void phase_final(const Args& A) {
    const int tid = threadIdx.x, lane = tid & 63, wave = tid >> 6;
    const float* OUT = (const float*)(A.ws + OFF_OUT);
    for (int r = blockIdx.x * 8 + wave; r < MS; r += gridDim.x * 8) {
        const f32x4* o4 = (const f32x4*)(OUT + (size_t)r * DM) + lane; const f32x4* x4 = (const f32x4*)(A.x + (size_t)r * DM) + lane;
        const f32x4* w4 = (const f32x4*)A.post_w + lane; f32x4* d4 = (f32x4*)(A.out + (size_t)r * DM) + lane;
        f32x4 v[4]; float s = 0.f;
#pragma unroll
        for (int j = 0; j < 4; ++j) { v[j] = o4[64 * j]; s += (v[j][0] * v[j][0] + v[j][1] * v[j][1]) + (v[j][2] * v[j][2] + v[j][3] * v[j][3]); }
        const float rs = rsqrtf(wave_sum(s) * (1.f / DM) + EPSF);
#pragma unroll
        for (int j = 0; j < 4; ++j) d4[64 * j] = x4[64 * j] + v[j] * rs * w4[64 * j];
    }
}


#define XB_TMO      128
#define XB_XCNT(j)  (256  + 64 * (j))
#define XB_XSUB(j)  (1280 + 64 * (j))
#define XB_XGEN(j)  (2304 + 64 * (j))
#define XB_TOP      3328
#define XB_TOPGEN   3392
#define XCD_BAR_WORDS 3456
#define XB_SPIN_CAP (1u << 18)
DI unsigned xb_ld(unsigned* p)              { return __hip_atomic_load(p, __ATOMIC_RELAXED, __HIP_MEMORY_SCOPE_AGENT); }
DI unsigned xb_add(unsigned* p, unsigned v) { return __hip_atomic_fetch_add(p, v, __ATOMIC_RELAXED, __HIP_MEMORY_SCOPE_AGENT); }
DI unsigned xb_xcc_id() { return (unsigned)__builtin_amdgcn_s_getreg((3 << 11) | 20) & 0xFu; }
#define XB_SPIN(cond, bar) do { unsigned _sp = 0; while (cond) { __builtin_amdgcn_s_sleep(1); \
    if ((++_sp & 255u) == 0u) { if (xb_ld(&(bar)[XB_TMO])) break; if (_sp > XB_SPIN_CAP) { atomicAdd(&(bar)[XB_TMO], 1u); break; } } } } while (0)
struct XcdBarrier { unsigned* bar; unsigned x; volatile LAS unsigned* st; };
DI XcdBarrier xcd_barrier_post(unsigned* bar, volatile LAS unsigned* st) {
    XcdBarrier b; b.bar = bar; b.x = xb_xcc_id(); b.st = st;
    if (threadIdx.x == 0) (void)xb_add(&bar[XB_XCNT(b.x)], 1u);
    return b;
}
DI void xcd_barrier_complete(unsigned* bar, unsigned x, unsigned& nloc, unsigned& nx) {
    const unsigned G = gridDim.x * gridDim.y * gridDim.z;
    unsigned sum, cnt, mine, sp = 0u;
    for (;;) {
        sum = 0u; cnt = 0u; mine = 0u;
#pragma unroll
        for (unsigned j = 0; j < 16; ++j) { const unsigned c = xb_ld(&bar[XB_XCNT(j)]); sum += c; cnt += (c > 0u) ? 1u : 0u; mine = (j == x) ? c : mine; }
        if (sum == G) break;
        __builtin_amdgcn_s_sleep(1);
        if ((++sp & 255u) == 0u) { if (xb_ld(&bar[XB_TMO])) break; if (sp > XB_SPIN_CAP) { atomicAdd(&bar[XB_TMO], 1u); break; } }
    }
    nloc = mine > 0u ? mine : 1u; nx = cnt > 0u ? cnt : 1u;
}
DI void xcd_barrier(const XcdBarrier& b) {
    asm volatile("s_waitcnt vmcnt(0)" ::: "memory");
    __syncthreads();
    if (threadIdx.x == 0) {
        unsigned* bar = b.bar;
        __builtin_amdgcn_s_waitcnt(0);
        unsigned nloc = b.st[0], nx = b.st[1];
        if (nloc == 0u) { xcd_barrier_complete(bar, b.x, nloc, nx); b.st[0] = nloc; b.st[1] = nx; }
        const unsigned old = xb_add(&bar[XB_XSUB(b.x)], 1u);
        const unsigned gen = old / nloc;
        if (old + 1u == (gen + 1u) * nloc) {
            __builtin_amdgcn_fence(__ATOMIC_RELEASE, "agent");
            asm volatile("s_waitcnt vmcnt(0)" ::: "memory");
            const unsigned og = xb_add(&bar[XB_TOP], 1u);
            const unsigned tg = og / nx;
            if (og + 1u == (tg + 1u) * nx) xb_add(&bar[XB_TOPGEN], 1u);
            else XB_SPIN(xb_ld(&bar[XB_TOPGEN]) == tg, bar);
            __builtin_amdgcn_fence(__ATOMIC_ACQUIRE, "agent");
            xb_add(&bar[XB_XGEN(b.x)], 1u);
            asm volatile("s_waitcnt vmcnt(0)" ::: "memory");
        } else {
            XB_SPIN(xb_ld(&bar[XB_XGEN(b.x)]) == gen, bar);
            __builtin_amdgcn_fence(__ATOMIC_ACQUIRE, "agent");
            asm volatile("s_waitcnt vmcnt(0)" ::: "memory");
        }
    }
    __syncthreads();
}

constexpr int NPHASE = 10;
__global__ void __launch_bounds__(512, 2) fwd_kernel(Args A) {
    extern __shared__ __attribute__((aligned(16))) unsigned char lds_raw[];
    LAS unsigned char* lds = (LAS unsigned char*)lds_raw;
    const int lo = A.ph_lo, hi = A.ph_hi, G = gridDim.x, bx = blockIdx.x;
    unsigned char* dob = (unsigned char*)A.out;
    volatile LAS unsigned* MISC = (volatile LAS unsigned*)(lds + LDS_BYTES - 256);
    if (threadIdx.x < 64) MISC[threadIdx.x] = 0u;
    __syncthreads();
    XcdBarrier bar; bar.bar = (unsigned*)(A.ws + OFF_CTL); bar.x = 0; bar.st = MISC + 8;
    if (hi - lo > 1) bar = xcd_barrier_post((unsigned*)(A.ws + OFF_CTL), MISC + 8);
    if (lo < 0) cg::this_grid().sync();
#ifndef PH_MASK
#define PH_MASK 0x3ff
#endif
#define IN(k) (((PH_MASK >> (k)) & 1) && lo <= (k) && (k) < hi)
#ifndef DUP_MASK
#define DUP_MASK 0
#endif
#define REP(k) _Pragma("unroll 1") for (int rep_ = 0; rep_ < (((DUP_MASK) >> (k)) & 1) + 1; ++rep_)
#define SEAM(k) do { if (IN(k) && IN((k) + 1)) xcd_barrier(bar); } while (0)
    if (IN(0)) REP(0) { phase_prologue(lds, A); __syncthreads(); }
    SEAM(0);
    if (IN(1)) REP(1) {
        pg8::Gemm g{(const bf16_t*)(dob + DO_U), (const bf16_t*)(dob + DO_WIN), MP, NA, DM, 0}; pg8::StaticOrder S; S.init(MP, NA, G, bx);
        EpiA E{A.ws, (const float*)(dob + DO_CS)};
        pg8::gemm_phase<EpiA, true>(lds, g, S, E);
    }
    SEAM(1);
    if (IN(2)) REP(2) {
        for (int u = bx; u < 2 * NB * AG * (NCH - 1); u += G) { const int half = u & 1, v = u >> 1, n = 1 + v % (NCH - 1), bg = v / (NCH - 1); attn_unit(lds, A, bg >> 1, bg & 1, n, half); }
        if (!A.dry) for (int u = bx; u < NB * NCH * RH; u += G) { const int h = u & 3, bn = u >> 2; ret_kv_unit(lds, A, bn / NCH, bn % NCH, h); }
    }
    SEAM(2);
    if (IN(3)) REP(3) phase_scan(A);
    SEAM(3);
    if (IN(4)) REP(4) {
        for (int u = bx; u < NB * (NCH - 1) * RH; u += G) { const int h = u & 3, bn = u >> 2; ret_out_unit(lds, A, bn / (NCH - 1), 1 + bn % (NCH - 1), h); }
    }
    SEAM(4);
    if (IN(5)) REP(5) {
        pg8::Gemm g{(const bf16_t*)(dob + DO_U), (const bf16_t*)(dob + DO_WIN) + (size_t)NA * DM, MS, NGATE, DM, 1}; pg8::StaticOrder S; S.init(MS, NGATE, G, bx);
        EpiGate E{A.ws, A.dry};
        pg8::gemm_phase<EpiGate, true>(lds, g, S, E);
    }
    SEAM(5);
    if (IN(6)) REP(6) {
        pg8::Gemm g{(const bf16_t*)(A.ws + OFF_OR), (const bf16_t*)(dob + DO_WRB), MS, DM, DM, 0}; pg8::StaticOrder S; S.init(MS, DM, G, bx);
        EpiPost<0> E{A.ws};
        pg8::gemm_phase<EpiPost<0>, false>(lds, g, S, E);
    }
    if (IN(6) && IN(7)) __syncthreads();
    if (IN(7)) REP(7) {
        pg8::Gemm g{(const bf16_t*)(A.ws + OFF_OA), (const bf16_t*)(dob + DO_WAB), MS, DM, DM, 0}; pg8::StaticOrder S; S.init(MS, DM, G, bx);
        EpiPost<1> E{A.ws};
        pg8::gemm_phase<EpiPost<1>, false>(lds, g, S, E);
    }
    SEAM(7);
    if (IN(8)) REP(8) {
        pg8::Gemm g{(const bf16_t*)(A.ws + OFF_MIX), (const bf16_t*)(dob + DO_WO), MS, DM, DM, 0}; pg8::StaticOrder S; S.init(MS, DM, G, bx);
        EpiPost<2> E{A.ws};
        pg8::gemm_phase<EpiPost<2>, false>(lds, g, S, E);
    }
    SEAM(8);
    if (IN(9)) REP(9) phase_final(A);
#undef IN
#undef SEAM
}

extern "C" void kernel_launch(void* const* d_in, const int* in_sizes, int n_in, void* d_out, int out_size, void* d_ws, size_t ws_size, hipStream_t stream) {
    static int grid = 0;
    if (grid == 0) {
        if (n_in != 12 || out_size != MS * DM || ws_size < OFF_CTL + CTL_BYTES) { fprintf(stderr, "kernel_launch: unexpected shapes (n_in %d out %d ws %zu)\n", n_in, out_size, ws_size); grid = -1; return; }
        int dev = 0, cus = 0, per_cu = 0;
        hipGetDevice(&dev); hipDeviceGetAttribute(&cus, hipDeviceAttributeMultiprocessorCount, dev);
        if (hipFuncSetAttribute((const void*)fwd_kernel, hipFuncAttributeMaxDynamicSharedMemorySize, LDS_BYTES) != hipSuccess) { fprintf(stderr, "kernel_launch: hipFuncSetAttribute failed\n"); grid = -1; return; }
        hipOccupancyMaxActiveBlocksPerMultiprocessor(&per_cu, (const void*)fwd_kernel, 512, LDS_BYTES);
        (void)hipGetLastError();
        if (per_cu < 1) { fprintf(stderr, "kernel_launch: occupancy query says %d blocks per CU\n", per_cu); per_cu = 1; }
        grid = cus;
    }
    if (grid < 0) return;
    Args a{};
    a.x = (const float*)d_in[0]; a.meta = (const float*)d_in[1]; a.pre_w = (const float*)d_in[2]; a.w_in = (const float*)d_in[3];
    a.dec_f = (const float*)d_in[4]; a.dec_b = (const float*)d_in[5]; a.ret_nw = (const float*)d_in[6]; a.w_rb = (const float*)d_in[7];
    a.sink = (const float*)d_in[8]; a.w_ab = (const float*)d_in[9]; a.w_o = (const float*)d_in[10]; a.post_w = (const float*)d_in[11];
    a.out = (float*)d_out; a.ws = (unsigned char*)d_ws;
#if MK_N_LAUNCHES == 1
    if (hipMemsetAsync((char*)d_ws + OFF_CTL, 0, CTL_BYTES, stream) != hipSuccess) { fprintf(stderr, "kernel_launch: memset failed\n"); return; }
    a.ph_lo = 0; a.ph_hi = NPHASE;
    void* args[] = {&a};
    hipError_t e = hipLaunchCooperativeKernel((const void*)fwd_kernel, dim3(grid), dim3(512), args, LDS_BYTES, stream);
    if (e != hipSuccess) fprintf(stderr, "cooperative launch failed: %s (grid %d)\n", hipGetErrorString(e), grid);
#else
    for (int p = 0; p < NPHASE; ++p) {
        if (p == 7) continue;
        a.ph_lo = p; a.ph_hi = (p == 6) ? 8 : p + 1;
        for (int rep = 0; rep < ((HDUP_MASK >> p) & 1) + 1; ++rep) { a.dry = (rep == 0 && ((HDUP_MASK >> p) & 1)) ? 1 : 0;
        hipLaunchKernelGGL(fwd_kernel, dim3(grid), dim3(512), LDS_BYTES, stream, a); }
    }
#endif
}
```

```cpp
#include <hip/hip_runtime.h>
#include <hip/hip_cooperative_groups.h>
#include <cstdio>
#include <cstdint>
namespace cg = cooperative_groups;

#ifndef HDUP_MASK
#define HDUP_MASK 0x0
#endif
#ifndef MK_N_LAUNCHES
#define MK_N_LAUNCHES 1
#endif

#define LAS __attribute__((address_space(3)))
#define DI __device__ __forceinline__
typedef unsigned short bf16_t;
typedef short bf16x8 __attribute__((ext_vector_type(8)));
typedef float f32x4 __attribute__((ext_vector_type(4)));
typedef float f32x2 __attribute__((ext_vector_type(2)));
typedef unsigned u32x4 __attribute__((ext_vector_type(4)));
typedef unsigned u32x2 __attribute__((ext_vector_type(2)));

constexpr int DM = 1024, NB = 2, SEQ = 8192, NMETA = 16, TT = SEQ + NMETA;
constexpr int CH = 128, MPAD = CH - NMETA;
constexpr int LP = TT + MPAD;
constexpr int NCH = LP / CH;
constexpr int MP = NB * LP;
constexpr int MS = NB * SEQ;
constexpr int RH = 4, RDK = 128, RDV = 256, AH = 8, AG = 2, AHD = 128;
constexpr int DIN = 7680, NA = 3584, NGATE = 4096;
constexpr float EPSF = 1e-6f;
constexpr float LOG2E = 1.4426950408889634f;

constexpr size_t OFF_RQ = 0;
constexpr size_t OFF_RK = OFF_RQ + (size_t)MP * 512 * 2;
constexpr size_t OFF_RV = OFF_RK + (size_t)MP * 512 * 2;
constexpr size_t OFF_AQ = OFF_RV + (size_t)MP * 1024 * 2;
constexpr size_t OFF_AK = OFF_AQ + (size_t)MP * 1024 * 2;
constexpr size_t OFF_AV = OFF_AK + (size_t)MP * 256 * 2;
constexpr size_t OFF_KVS = OFF_AV + (size_t)MP * 256 * 2;
constexpr size_t KVS_BYTES = (size_t)2 * NB * NCH * RH * 32768 * 2;
constexpr size_t OFF_OR = OFF_KVS + KVS_BYTES;
constexpr size_t OFF_OA = OFF_OR + (size_t)MS * 1024 * 2;
constexpr size_t WS_END = OFF_OA + (size_t)MS * 1024 * 2;
constexpr size_t OFF_SGR = OFF_RQ, OFF_SGA = OFF_RQ + (size_t)MS * 1024 * 2;
constexpr size_t OFF_MIX = OFF_AQ;
constexpr size_t OFF_PART = OFF_KVS;
constexpr size_t OFF_OUT = OFF_OR;
static_assert(OFF_SGA + (size_t)MS * 1024 * 2 <= OFF_AQ, "gate overlay");
static_assert((size_t)MS * 1024 * 4 <= KVS_BYTES, "part overlay");
constexpr size_t OFF_CTL = WS_END;
constexpr size_t CTL_BYTES = 36864;
constexpr size_t OFF_XBUF = OFF_CTL + CTL_BYTES;
constexpr size_t OFF_WO = OFF_XBUF + (size_t)MS * 4 * 4;
constexpr size_t WS_NEED = OFF_WO + (size_t)1024 * 1024 * 2;
static_assert(WS_NEED <= 268435456ull, "ws");
constexpr size_t DO_U = 0;
constexpr size_t DO_WIN = DO_U + (size_t)MP * 1024 * 2;
constexpr size_t DO_WRB = DO_WIN + (size_t)DIN * 1024 * 2;
constexpr size_t DO_WAB = DO_WRB + (size_t)1024 * 1024 * 2;
constexpr size_t DO_WO = DO_WAB + (size_t)1024 * 1024 * 2;
constexpr size_t DO_CS = DO_WO + (size_t)1024 * 1024 * 2;
static_assert(DO_CS + (size_t)TT * 64 * 8 <= (size_t)MS * 1024 * 4, "d_out scratch");

constexpr int LDS_BYTES = 163840;
constexpr int LDT = 136;

typedef __bf16 bf16v2 __attribute__((ext_vector_type(2)));
DI unsigned cvt_pk_bf16(float lo, float hi) { const f32x2 v = {lo, hi}; const bf16v2 b = __builtin_convertvector(v, bf16v2); return __builtin_bit_cast(unsigned, b); }
DI float bf2f(unsigned short b) { return __uint_as_float(((unsigned)b) << 16); }
DI float bflo(unsigned w) { return __uint_as_float(w << 16); }
DI float bfhi(unsigned w) { return __uint_as_float(w & 0xffff0000u); }
DI float wave_sum(float v) {
#pragma unroll
    for (int o = 1; o < 64; o <<= 1) v += __shfl_xor(v, o);
    return v;
}
DI f32x4 mfma16(bf16x8 a, bf16x8 b, f32x4 c) { return __builtin_amdgcn_mfma_f32_16x16x32_bf16(a, b, c, 0, 0, 0); }
#define LDS_WAIT() asm volatile("s_waitcnt lgkmcnt(0)" ::: "memory")

namespace pg8 {
constexpr int BM = 256, BK = 64, HALF = 128, HTB = HALF * BK * 2, STAGE_BYTES = 8 * HTB, NXCD = 8, WGM = 8;
DI int lds_byte(int r, int c) { const int st = (r >> 4) * 2 + (c >> 5), rr = r & 15, cc = c & 31, ob = rr * 64 + cc * 2; return st * 1024 + (ob ^ (((ob >> 9) & 1) << 5)); }
DI void stage_rc(int b, int& R, int& C) { const int st = b / 1024, sb = b % 1024, swz = sb ^ (((sb >> 9) & 1) << 5); R = (st >> 1) * 16 + swz / 64; C = (st & 1) * 32 + (swz % 64) / 2; }
struct Unit { int pm, pn; };
struct Gemm { const bf16_t* A; const bf16_t* Bt; int M, N, K, amode; };
DI size_t a_row0(const Gemm& g, int pm) { return g.amode ? (size_t)((pm >> 5) * LP + 128 + (pm & 31) * 256) : (size_t)pm * 256; }
struct StaticOrder {
    int nM, nN, nwg, G, c;
    DI void init(int M, int N, int G_, int c_) { nM = M / BM; nN = N / BM; nwg = nM * nN; G = G_; c = c_; }
    DI bool next(int i, Unit& u) const {
        const long L = (long)i * G + c; if (L >= nwg) return false;
        int wgid = (int)L; { const int q = nwg / NXCD, r = nwg % NXCD, xcd = wgid % NXCD, off = wgid / NXCD; wgid = (xcd < r ? xcd * (q + 1) : r * (q + 1) + (xcd - r) * q) + off; }
        const int nig = WGM * nN, gid = wgid / nig, fm = gid * WGM, gsz = (nM - fm) < WGM ? (nM - fm) : WGM;
        u.pm = fm + ((wgid % nig) % gsz); u.pn = (wgid % nig) / gsz; return true;
    }
};
template <class Epi, bool ALIGN_EPI>
DI void gemm_phase(LAS unsigned char* lds, const Gemm g, const StaticOrder& S, const Epi& E) {
    const int tid = threadIdx.x, wid = __builtin_amdgcn_readfirstlane(tid >> 6), lane = tid & 63, wr = wid >> 2, wc = wid & 3, fr = lane & 15, fq = lane >> 4;
    const int K = g.K, nt = K / BK;
    unsigned voffA[2];
#pragma unroll
    for (int i = 0; i < 2; ++i) { int R, C; stage_rc(tid * 16 + i * 8192, R, C); voffA[i] = (unsigned)(R * K + C) * 2u; }
    const size_t kstep = (size_t)(BK * 2);
    const size_t hstep = (size_t)HALF * K * 2;
    const size_t tstep = 2 * hstep;
    const size_t rowb = (size_t)K * 2;
    const unsigned ldsw = (unsigned)wid * 1024u;
    const int aoff = lds_byte(wr * 64 + fr, fq * 8), boff = lds_byte(wc * 32 + fr, fq * 8);
#define PG8_SA(b, h) (((b) * 2 + (h)) * HTB)
#define PG8_SB(b, h) ((4 + (b) * 2 + (h)) * HTB)
#define PG8_STAGE(bufoff, gbase, voff) do { _Pragma("unroll") for (int _i = 0; _i < 2; ++_i) \
        __builtin_amdgcn_global_load_lds((const unsigned*)((const char*)(gbase) + (voff)[_i]), (LAS unsigned*)(lds + (bufoff) + ldsw + _i * 8192), 16, 0, 0); } while (0)
#define PG8_LDA(dst, b, h) do { _Pragma("unroll") for (int m = 0; m < 4; ++m) _Pragma("unroll") for (int k = 0; k < 2; ++k) dst[m][k] = *(const LAS bf16x8*)(lds + PG8_SA(b, h) + aoff + m * 2048 + k * 1024); } while (0)
#define PG8_LDB(dst, b, h) do { _Pragma("unroll") for (int n = 0; n < 2; ++n) _Pragma("unroll") for (int k = 0; k < 2; ++k) dst[n][k] = *(const LAS bf16x8*)(lds + PG8_SB(b, h) + boff + n * 2048 + k * 1024); } while (0)
#define PG8_MMA(ai, bj, At, Bt) do { __builtin_amdgcn_s_setprio(1); _Pragma("unroll") for (int m = 0; m < 4; ++m) _Pragma("unroll") for (int n = 0; n < 2; ++n) _Pragma("unroll") for (int k = 0; k < 2; ++k) \
        acc[ai][bj][m][n] = __builtin_amdgcn_mfma_f32_16x16x32_bf16(Bt[n][k], At[m][k], acc[ai][bj][m][n], 0, 0, 0); __builtin_amdgcn_s_setprio(0); } while (0)
#define PG8_WAIT_V(n) asm volatile("s_waitcnt vmcnt(" #n ")" ::: "memory")
#define PG8_WAIT_L(n) asm volatile("s_waitcnt lgkmcnt(" #n ")" ::: "memory")
#define PG8_BAR __builtin_amdgcn_s_barrier()
#define PG8_SCHED __builtin_amdgcn_sched_barrier(0)
    Unit cur, nxt; int ui = 0;
    if (!S.next(0, cur)) return;
    f32x4 acc[2][2][4][2];
#pragma unroll
    for (int a = 0; a < 2; ++a)
#pragma unroll
        for (int b = 0; b < 2; ++b)
#pragma unroll
            for (int m = 0; m < 4; ++m)
#pragma unroll
                for (int n = 0; n < 2; ++n) acc[a][b][m][n] = (f32x4){0.f, 0.f, 0.f, 0.f};
    bf16x8 At[4][2], B0[2][2], B1[2][2];
    const char* cA = (const char*)g.A + a_row0(g, cur.pm) * rowb; const char* cB = (const char*)g.Bt + (size_t)cur.pn * tstep;
    PG8_STAGE(PG8_SB(0, 0), cB, voffA); PG8_STAGE(PG8_SB(0, 1), cB + hstep, voffA); PG8_STAGE(PG8_SA(0, 0), cA, voffA); PG8_STAGE(PG8_SA(0, 1), cA + hstep, voffA);
    if (wr == 1) PG8_BAR;
    PG8_WAIT_V(2); PG8_BAR;
    PG8_STAGE(PG8_SB(1, 0), cB + kstep, voffA); PG8_STAGE(PG8_SA(1, 0), cA + kstep, voffA); PG8_STAGE(PG8_SB(1, 1), cB + hstep + kstep, voffA);
    PG8_WAIT_V(6); PG8_BAR;
    for (;;) {
        const bool has_next = S.next(ui + 1, nxt);
        const char* nA = has_next ? (const char*)g.A + a_row0(g, nxt.pm) * rowb : cA; const char* nB = has_next ? (const char*)g.Bt + (size_t)nxt.pn * tstep : cB;
        for (int t = 0; t < nt; t += 2) {
            const bool last = (t == nt - 2);
            const char* a1 = cA + (size_t)(t + 1) * kstep;
            const char* a2 = last ? nA : cA + (size_t)(t + 2) * kstep; const char* b2 = last ? nB : cB + (size_t)(t + 2) * kstep;
            const char* a3 = a2 + kstep; const char* b3 = b2 + kstep;
            PG8_LDB(B0, 0, 0); PG8_LDB(B1, 0, 1); PG8_SCHED; PG8_LDA(At, 0, 0); PG8_STAGE(PG8_SA(1, 1), a1 + hstep, voffA);
            PG8_WAIT_V(8); PG8_WAIT_L(0); PG8_BAR; PG8_MMA(0, 0, At, B0); PG8_MMA(0, 1, At, B1); PG8_BAR; PG8_SCHED;
            PG8_LDA(At, 0, 1); PG8_STAGE(PG8_SB(0, 0), b2, voffA); PG8_STAGE(PG8_SB(0, 1), b2 + hstep, voffA); PG8_STAGE(PG8_SA(0, 0), a2, voffA);
            PG8_WAIT_V(8); PG8_WAIT_L(0); PG8_BAR; PG8_MMA(1, 0, At, B0); PG8_MMA(1, 1, At, B1); PG8_BAR; PG8_SCHED;
            PG8_LDB(B0, 1, 0); PG8_LDB(B1, 1, 1); PG8_SCHED; PG8_LDA(At, 1, 0); PG8_STAGE(PG8_SA(0, 1), a2 + hstep, voffA);
            PG8_WAIT_V(8); PG8_WAIT_L(0); PG8_BAR; PG8_MMA(0, 0, At, B0); PG8_MMA(0, 1, At, B1); PG8_BAR; PG8_SCHED;
            PG8_LDA(At, 1, 1); PG8_STAGE(PG8_SB(1, 0), b3, voffA); PG8_STAGE(PG8_SB(1, 1), b3 + hstep, voffA); PG8_STAGE(PG8_SA(1, 0), a3, voffA);
            PG8_WAIT_V(8); PG8_WAIT_L(0); PG8_BAR; PG8_MMA(1, 0, At, B0); PG8_MMA(1, 1, At, B1); PG8_BAR; PG8_SCHED;
        }
        if constexpr (ALIGN_EPI) { if (wr == 0) PG8_BAR; }
        if constexpr (!Epi::AFTER_DRAIN) E(acc, cur, wr, wc, fr, fq);
        if (!has_next) break;
#pragma unroll
        for (int a = 0; a < 2; ++a)
#pragma unroll
            for (int b = 0; b < 2; ++b)
#pragma unroll
                for (int m = 0; m < 4; ++m)
#pragma unroll
                    for (int n = 0; n < 2; ++n) acc[a][b][m][n] = (f32x4){0.f, 0.f, 0.f, 0.f};
        cur = nxt; cA = nA; cB = nB; ++ui;
        if constexpr (ALIGN_EPI) { if (wr == 1) PG8_BAR; }
    }
    PG8_WAIT_V(0);
    if constexpr (!ALIGN_EPI) { if (wr == 0) PG8_BAR; }
    PG8_BAR;
    if constexpr (Epi::AFTER_DRAIN) E.fused(acc, cur, wr, wc, fr, fq, lds, wid, lane);
#undef PG8_SA
#undef PG8_SB
#undef PG8_STAGE
#undef PG8_LDA
#undef PG8_LDB
#undef PG8_MMA
#undef PG8_WAIT_V
#undef PG8_WAIT_L
#undef PG8_BAR
#undef PG8_SCHED
}
}

typedef f32x4 Acc[2][2][4][2];
struct EpiA {
    static constexpr bool AFTER_DRAIN = false;
    unsigned char* ws; const float* cs;
    DI void operator()(const Acc& acc, const pg8::Unit& u, int wr, int wc, int fr, int fq) const {
        const int pn = u.pn; size_t off; int ld, colb, rot; float sc;
        if (pn < 2) { off = OFF_RQ; ld = 512; colb = pn * 256; rot = 1; sc = 1.f; }
        else if (pn < 4) { off = OFF_RK; ld = 512; colb = (pn - 2) * 256; rot = 1; sc = 0.08838834764831845f; }
        else if (pn < 8) { off = OFF_RV; ld = 1024; colb = (pn - 4) * 256; rot = 0; sc = 1.f; }
        else if (pn < 12) { off = OFF_AQ; ld = 1024; colb = (pn - 8) * 256; rot = 1; sc = 0.08838834764831845f * LOG2E; }
        else if (pn == 12) { off = OFF_AK; ld = 256; colb = 0; rot = 1; sc = 1.f; }
        else { off = OFF_AV; ld = 256; colb = 0; rot = 0; sc = 1.f; }
        bf16_t* dst = (bf16_t*)(ws + off);
#pragma unroll
        for (int ai = 0; ai < 2; ++ai)
#pragma unroll
            for (int m = 0; m < 4; ++m) {
                const int r = u.pm * 256 + ai * 128 + wr * 64 + m * 16 + fr;
                const int p = r >= LP ? r - LP : r; const int t = p >= MPAD ? p - MPAD : 0;
                f32x4 c4 = (f32x4){sc, sc, sc, sc}, s4 = (f32x4){0.f, 0.f, 0.f, 0.f};
                if (rot) { const f32x4* pc = (const f32x4*)(cs + ((size_t)t * 64 + 16 * wc + 4 * fq) * 2); const f32x4 x0 = pc[0], x1 = pc[1];
                    c4 = (f32x4){x0[0], x0[2], x1[0], x1[2]} * sc; s4 = (f32x4){x0[1], x0[3], x1[1], x1[3]} * sc; }
                bf16_t* rowp = dst + (size_t)r * ld + colb + 16 * wc + 4 * fq;
#pragma unroll
                for (int bj = 0; bj < 2; ++bj) {
                    const f32x4 v0 = acc[ai][bj][m][0], v1 = acc[ai][bj][m][1];
                    const f32x4 o0 = v0 * c4 - v1 * s4, o1 = v1 * c4 + v0 * s4;
                    u32x2 w0, w1; w0.x = cvt_pk_bf16(o0[0], o0[1]); w0.y = cvt_pk_bf16(o0[2], o0[3]); w1.x = cvt_pk_bf16(o1[0], o1[1]); w1.y = cvt_pk_bf16(o1[2], o1[3]);
                    *(u32x2*)(rowp + bj * 128) = w0; *(u32x2*)(rowp + bj * 128 + 64) = w1;
                }
            }
    }
};
DI float sigmoidf_(float x) { return __builtin_amdgcn_rcpf(1.f + __expf(-x)); }
struct EpiGate {
    static constexpr bool AFTER_DRAIN = false;
    unsigned char* ws; int dry;
    DI void operator()(const Acc& acc, const pg8::Unit& u, int wr, int wc, int fr, int fq) const {
        const int seg = u.pn >> 2, colb = (u.pn & 3) * 256;
        bf16_t* dst = (bf16_t*)(ws + (seg == 0 ? OFF_OR : seg == 1 ? OFF_OA : seg == 2 ? OFF_SGR : OFF_SGA));
#pragma unroll
        for (int ai = 0; ai < 2; ++ai)
#pragma unroll
            for (int m = 0; m < 4; ++m) {
                const int r = u.pm * 256 + ai * 128 + wr * 64 + m * 16 + fr;
#pragma unroll
                for (int bj = 0; bj < 2; ++bj)
#pragma unroll
                    for (int n = 0; n < 2; ++n) {
                        bf16_t* p = dst + (size_t)r * 1024 + colb + bj * 128 + wc * 32 + n * 16 + 4 * fq;
                        const f32x4 a = acc[ai][bj][m][n]; f32x4 o;
#pragma unroll
                        for (int e = 0; e < 4; ++e) o[e] = sigmoidf_(a[e]);
                        if (seg < 2) { const u32x2 w = *(const u32x2*)p; o = o * a; if (dry) o = (f32x4){1.f, 1.f, 1.f, 1.f}; o[0] *= bflo(w.x); o[1] *= bfhi(w.x); o[2] *= bflo(w.y); o[3] *= bfhi(w.y); }
                        u32x2 w2; w2.x = cvt_pk_bf16(o[0], o[1]); w2.y = cvt_pk_bf16(o[2], o[3]); *(u32x2*)p = w2;
                    }
            }
    }
};
template <int MODE> struct EpiPost {
    static constexpr bool AFTER_DRAIN = false;
    unsigned char* ws;
    DI void operator()(const Acc& acc, const pg8::Unit& u, int wr, int wc, int fr, int fq) const {
#pragma unroll
        for (int ai = 0; ai < 2; ++ai)
#pragma unroll
            for (int m = 0; m < 4; ++m) {
                const int r = u.pm * 256 + ai * 128 + wr * 64 + m * 16 + fr;
#pragma unroll
                for (int bj = 0; bj < 2; ++bj)
#pragma unroll
                    for (int n = 0; n < 2; ++n) {
                        const size_t idx = (size_t)r * 1024 + u.pn * 256 + bj * 128 + wc * 32 + n * 16 + 4 * fq;
                        const f32x4 a = acc[ai][bj][m][n];
                        if (MODE == 2) { *(f32x4*)((float*)(ws + OFF_OUT) + idx) = a; }
                        else {
                            const u32x2 w = *(const u32x2*)((const bf16_t*)(ws + (MODE == 0 ? OFF_SGR : OFF_SGA)) + idx);
                            f32x4 o = (f32x4){a[0] * bflo(w.x), a[1] * bfhi(w.x), a[2] * bflo(w.y), a[3] * bfhi(w.y)};
                            if (MODE == 0) { *(f32x4*)((float*)(ws + OFF_PART) + idx) = o; }
                            else { o = o + *(const f32x4*)((const float*)(ws + OFF_PART) + idx);
                                u32x2 w2; w2.x = cvt_pk_bf16(o[0], o[1]); w2.y = cvt_pk_bf16(o[2], o[3]); *(u32x2*)((bf16_t*)(ws + OFF_MIX) + idx) = w2; }
                        }
                    }
            }
    }
};

struct EpiOutNorm {
    static constexpr bool AFTER_DRAIN = true;
    const float* x; const float* post_w; float* out; float* xbuf; unsigned* cnt;
    DI void fused(Acc& acc, const pg8::Unit& u, int wr, int wc, int fr, int fq, LAS unsigned char* lds, int wid, int lane) const {
        LAS float* P = (LAS float*)lds;
        LAS float* R = (LAS float*)(lds + 4096);
        const int tid = wid * 64 + lane;
#pragma unroll
        for (int ai = 0; ai < 2; ++ai)
#pragma unroll
            for (int m = 0; m < 4; ++m) {
                float s = 0.f;
#pragma unroll
                for (int bj = 0; bj < 2; ++bj)
#pragma unroll
                    for (int n = 0; n < 2; ++n) { const f32x4 a = acc[ai][bj][m][n]; s += (a[0] * a[0] + a[1] * a[1]) + (a[2] * a[2] + a[3] * a[3]); }
                s += __shfl_xor(s, 16); s += __shfl_xor(s, 32);
                if (fq == 0) P[(ai * 128 + wr * 64 + m * 16 + fr) * 4 + wc] = s;
            }
        __syncthreads();
        if (tid < 256) { const float tot = (P[tid * 4 + 0] + P[tid * 4 + 1]) + (P[tid * 4 + 2] + P[tid * 4 + 3]);
            __hip_atomic_store(xbuf + ((size_t)u.pm * 256 + tid) * 4 + u.pn, tot, __ATOMIC_RELAXED, __HIP_MEMORY_SCOPE_AGENT); }
        asm volatile("s_waitcnt vmcnt(0)" ::: "memory");
        __syncthreads();
        if (tid == 0) {
            unsigned* c = cnt + 64 * u.pm;
            __hip_atomic_fetch_add(c, 1u, __ATOMIC_RELAXED, __HIP_MEMORY_SCOPE_AGENT);
            unsigned sp = 0;
            while (__hip_atomic_load(c, __ATOMIC_RELAXED, __HIP_MEMORY_SCOPE_AGENT) < 4u) { __builtin_amdgcn_s_sleep(1); if (++sp > (1u << 22)) break; }
            __builtin_amdgcn_fence(__ATOMIC_ACQUIRE, "agent");
        }
        __syncthreads();
        if (tid < 256) { const float* xb = xbuf + ((size_t)u.pm * 256 + tid) * 4; float t = 0.f;
#pragma unroll
            for (int k = 0; k < 4; ++k) t += __hip_atomic_load(xb + k, __ATOMIC_RELAXED, __HIP_MEMORY_SCOPE_AGENT);
            R[tid] = rsqrtf(t * (1.f / DM) + EPSF); }
        __syncthreads();
#pragma unroll
        for (int ai = 0; ai < 2; ++ai)
#pragma unroll
            for (int m = 0; m < 4; ++m) {
                const int rl = ai * 128 + wr * 64 + m * 16 + fr; const float rs = R[rl]; const size_t r = (size_t)u.pm * 256 + rl;
#pragma unroll
                for (int bj = 0; bj < 2; ++bj)
#pragma unroll
                    for (int n = 0; n < 2; ++n) { const int c = u.pn * 256 + bj * 128 + wc * 32 + n * 16 + 4 * fq;
                        const f32x4 xv = *(const f32x4*)(x + r * DM + c), wv = *(const f32x4*)(post_w + c);
                        *(f32x4*)(out + r * DM + c) = xv + acc[ai][bj][m][n] * rs * wv; }
            }
    }
};

struct Args {
    const float* x; const float* meta; const float* pre_w; const float* w_in; const float* dec_f; const float* dec_b; const float* ret_nw;
    const float* w_rb; const float* sink; const float* w_ab; const float* w_o; const float* post_w;
    float* out; unsigned char* ws; int ph_lo, ph_hi, dry, pad_;
};

DI int win_dst_row(int c) {
    int d;
    if (c < 2048) d = c; else if (c < 3072) d = 3584 + (c - 2048); else if (c < 4608) d = 2048 + (c - 3072); else d = c;
    if (d < NA) { const int q = d & 127; d = (d & ~127) + 32 * ((q >> 4) & 3) + 16 * (q >> 6) + (q & 15); }
    return d;
}
template <bool WIN>
DI void p0_transpose_item(const float* W, int K, int N, bf16_t* WT, LAS float* scr, int item, int lane) {
    const int nblk = N / 32, kb = item / nblk, nb = item % nblk, k0 = 64 * kb, n0 = 32 * nb;
#pragma unroll 8
    for (int i = 0; i < 32; ++i) { const int kk = 2 * i + (lane >> 5); scr[kk * 33 + (lane & 31)] = W[(size_t)(k0 + kk) * N + n0 + (lane & 31)]; }
    LDS_WAIT();
    const int c = lane & 7;
#pragma unroll
    for (int j = 0; j < 4; ++j) { const int n = (lane >> 3) + 8 * j; const LAS float* s = scr + (8 * c) * 33 + n;
        u32x4 o; o.x = cvt_pk_bf16(s[0 * 33], s[1 * 33]); o.y = cvt_pk_bf16(s[2 * 33], s[3 * 33]); o.z = cvt_pk_bf16(s[4 * 33], s[5 * 33]); o.w = cvt_pk_bf16(s[6 * 33], s[7 * 33]);
        const int drow = WIN ? win_dst_row(n0 + n) : (n0 + n);
        *(u32x4*)(WT + (size_t)drow * K + k0 + 8 * c) = o; }
    LDS_WAIT();
}
DI void phase_prologue(LAS unsigned char* lds, const Args& A) {
    const int tid = threadIdx.x, lane = tid & 63, wave = tid >> 6;
    const int gw = blockIdx.x * 8 + wave, NGW = gridDim.x * 8;
    unsigned char* dob = (unsigned char*)A.out;
    LAS float* scr = (LAS float*)(lds + wave * 16384);
    constexpr int I_IN = (DM / 64) * (DIN / 32), I_SQ = (DM / 64) * (DM / 32);
    for (int it = gw; it < I_IN + 3 * I_SQ; it += NGW) {
        int r = it;
        if (r < I_IN) { p0_transpose_item<true>(A.w_in, DM, DIN, (bf16_t*)(dob + DO_WIN), scr, r, lane); continue; } r -= I_IN;
        if (r < I_SQ) { p0_transpose_item<false>(A.w_rb, DM, DM, (bf16_t*)(dob + DO_WRB), scr, r, lane); continue; } r -= I_SQ;
        if (r < I_SQ) { p0_transpose_item<false>(A.w_ab, DM, DM, (bf16_t*)(dob + DO_WAB), scr, r, lane); continue; } r -= I_SQ;
        p0_transpose_item<false>(A.w_o, DM, DM, (bf16_t*)(A.ws + OFF_WO), scr, r, lane);
    }
    bf16_t* U = (bf16_t*)(dob + DO_U);
    for (int r = gw; r < MP; r += NGW) {
        const int b = r >= LP ? 1 : 0, p = r - b * LP;
        u32x2* o8 = (u32x2*)(U + (size_t)r * DM) + lane;
        if (p < MPAD) {
#pragma unroll
            for (int j = 0; j < 4; ++j) o8[64 * j] = (u32x2){0u, 0u};
            continue; }
        const int t = p - MPAD;
        const float* src = t < NMETA ? A.meta + (size_t)t * DM : A.x + ((size_t)b * SEQ + (t - NMETA)) * DM;
        const f32x4* xr = (const f32x4*)src + lane; const f32x4* wr4 = (const f32x4*)A.pre_w + lane;
        f32x4 v[4]; float s = 0.f;
#pragma unroll
        for (int j = 0; j < 4; ++j) { v[j] = xr[64 * j]; s += (v[j][0] * v[j][0] + v[j][1] * v[j][1]) + (v[j][2] * v[j][2] + v[j][3] * v[j][3]); }
        const float rs = rsqrtf(wave_sum(s) * (1.f / DM) + EPSF);
#pragma unroll
        for (int j = 0; j < 4; ++j) { const f32x4 w = wr4[64 * j]; const f32x4 y = v[j] * rs * w; o8[64 * j] = (u32x2){cvt_pk_bf16(y[0], y[1]), cvt_pk_bf16(y[2], y[3])}; }
    }
    float* cs = (float*)(dob + DO_CS);
    for (int i = blockIdx.x * 512 + tid; i < TT * 64; i += gridDim.x * 512) {
        const int t = i >> 6, f = i & 63;
        const float inv = (float)exp2(-(double)f * (2.0 / 128.0) * 13.287712379549449);
        const float ang = (float)t * inv;
        double rev = (double)ang * 0.15915494309189535; rev -= floor(rev);
        const float fr = (float)rev;
        cs[2 * i] = __builtin_amdgcn_cosf(fr); cs[2 * i + 1] = __builtin_amdgcn_sinf(fr);
    }
}

template <int ROWS> DI void stage_plain(LAS bf16_t* dst, const bf16_t* src, int ld, int tid) {
#pragma unroll
    for (int i = 0; i < ROWS / 32; ++i) { const int id = tid + 512 * i, row = id >> 4, c8 = id & 15;
        const u32x4 v = *(const u32x4*)(src + (size_t)row * ld + c8 * 8); *(LAS u32x4*)(dst + row * LDT + c8 * 8) = v; }
}
template <int NCOLS> DI void stage_transposed(LAS bf16_t* dst, const bf16_t* src, int ld, int tid) {
    const int j = tid & 127;
#pragma unroll
    for (int i = 0; i < NCOLS / 32; ++i) { const int g8 = (tid >> 7) + 4 * i;
        const u32x4 v = *(const u32x4*)(src + (size_t)j * ld + g8 * 8);
        LAS bf16_t* d = dst + (g8 * 8) * LDT + j;
        d[0 * LDT] = (bf16_t)(v.x & 0xffff); d[1 * LDT] = (bf16_t)(v.x >> 16); d[2 * LDT] = (bf16_t)(v.y & 0xffff); d[3 * LDT] = (bf16_t)(v.y >> 16);
        d[4 * LDT] = (bf16_t)(v.z & 0xffff); d[5 * LDT] = (bf16_t)(v.z >> 16); d[6 * LDT] = (bf16_t)(v.w & 0xffff); d[7 * LDT] = (bf16_t)(v.w >> 16); }
}
typedef short s16x4 __attribute__((ext_vector_type(4)));
DI int tr_lane_off(int ld, int lane) { return (8 * (lane >> 4) + ((lane & 15) >> 2)) * ld + 4 * (lane & 3); }
DI bf16x8 tr_frag(const LAS bf16_t* p, int ld) {
    const s16x4 lo = __builtin_amdgcn_ds_read_tr16_b64_v4i16((LAS s16x4*)p);
    const s16x4 hi = __builtin_amdgcn_ds_read_tr16_b64_v4i16((LAS s16x4*)(p + 4 * ld));
    return __builtin_shufflevector(lo, hi, 0, 1, 2, 3, 4, 5, 6, 7);
}
constexpr int VLD = 264;
template <int ROWS> DI void stage_plain256(LAS bf16_t* dst, const bf16_t* src, int ld, int tid) {
#pragma unroll
    for (int i = 0; i < ROWS / 16; ++i) { const int id = tid + 512 * i, row = id >> 5, c8 = id & 31;
        const u32x4 v = *(const u32x4*)(src + (size_t)row * ld + c8 * 8); *(LAS u32x4*)(dst + row * VLD + c8 * 8) = v; }
}
DI bf16x8 scale_frag(bf16x8 a, float s) {
    const u32x4 w = __builtin_bit_cast(u32x4, a); u32x4 o;
    o.x = cvt_pk_bf16(bflo(w.x) * s, bfhi(w.x) * s); o.y = cvt_pk_bf16(bflo(w.y) * s, bfhi(w.y) * s);
    o.z = cvt_pk_bf16(bflo(w.z) * s, bfhi(w.z) * s); o.w = cvt_pk_bf16(bflo(w.w) * s, bfhi(w.w) * s);
    return __builtin_bit_cast(bf16x8, o);
}
DI float log2_sigmoid(float d) { return -log2f(1.f + expf(-d)); }
DI size_t kvs_off(int dir, int b, int n, int h) { return ((((size_t)dir * NB + b) * NCH + n) * RH + h) * 32768; }

DI void ret_kv_unit(LAS unsigned char* lds, const Args& A, int b, int n, int h) {
    const int tid = threadIdx.x, lane = tid & 63, w = tid >> 6, fr = lane & 15, fq = lane >> 4;
    LAS bf16_t* Vr = (LAS bf16_t*)lds;
    LAS bf16_t* Kf = Vr + 128 * VLD;
    LAS bf16_t* Kb = Kf + 128 * LDT;
    const float lgf = log2_sigmoid(A.dec_f[h]), lgb = log2_sigmoid(A.dec_b[h]);
    const size_t row0 = (size_t)b * LP + (size_t)n * CH;
    const bf16_t* RK = (const bf16_t*)(A.ws + OFF_RK) + row0 * 512 + h * 128;
    const bf16_t* RV = (const bf16_t*)(A.ws + OFF_RV) + row0 * 1024 + h * 256;
    stage_plain256<128>(Vr, RV, 1024, tid);
#pragma unroll
    for (int i = 0; i < 4; ++i) { const int id = tid + 512 * i, j = id >> 4, c8 = id & 15;
        const float wf = exp2f((float)(127 - j) * lgf), wb = exp2f((float)j * lgb);
        const u32x4 v = *(const u32x4*)(RK + (size_t)j * 512 + c8 * 8);
        const float f[8] = {bflo(v.x), bfhi(v.x), bflo(v.y), bfhi(v.y), bflo(v.z), bfhi(v.z), bflo(v.w), bfhi(v.w)};
        u32x4 of, ob;
        of.x = cvt_pk_bf16(f[0] * wf, f[1] * wf); of.y = cvt_pk_bf16(f[2] * wf, f[3] * wf); of.z = cvt_pk_bf16(f[4] * wf, f[5] * wf); of.w = cvt_pk_bf16(f[6] * wf, f[7] * wf);
        ob.x = cvt_pk_bf16(f[0] * wb, f[1] * wb); ob.y = cvt_pk_bf16(f[2] * wb, f[3] * wb); ob.z = cvt_pk_bf16(f[4] * wb, f[5] * wb); ob.w = cvt_pk_bf16(f[6] * wb, f[7] * wb);
        *(LAS u32x4*)(Kf + j * LDT + c8 * 8) = of; *(LAS u32x4*)(Kb + j * LDT + c8 * 8) = ob; }
    __syncthreads();
    const int trV = tr_lane_off(VLD, lane), trK = tr_lane_off(LDT, lane);
#pragma unroll 1
    for (int dir = 0; dir < 2; ++dir) {
        const LAS bf16_t* Kx = dir ? Kb : Kf;
        f32x4 aF[2][8];
#pragma unroll
        for (int mt = 0; mt < 2; ++mt)
#pragma unroll
            for (int nt = 0; nt < 8; ++nt) aF[mt][nt] = (f32x4){0.f, 0.f, 0.f, 0.f};
#pragma unroll
        for (int ks = 0; ks < 4; ++ks) {
            bf16x8 a[2];
#pragma unroll
            for (int mt = 0; mt < 2; ++mt) a[mt] = tr_frag(Vr + trV + (32 * ks) * VLD + 32 * w + 16 * mt, VLD);
#pragma unroll
            for (int nt = 0; nt < 8; ++nt) {
                const bf16x8 bf = tr_frag(Kx + trK + (32 * ks) * LDT + 16 * nt, LDT);
#pragma unroll
                for (int mt = 0; mt < 2; ++mt) aF[mt][nt] = mfma16(bf, a[mt], aF[mt][nt]);
            }
        }
        bf16_t* of = (bf16_t*)(A.ws + OFF_KVS) + kvs_off(dir, b, n, h);
#pragma unroll
        for (int mt = 0; mt < 2; ++mt)
#pragma unroll
            for (int nt = 0; nt < 8; ++nt) { const int o = (32 * w + 16 * mt + fr) * 128 + 16 * nt + 4 * fq;
                *(u32x2*)(of + o) = (u32x2){cvt_pk_bf16(aF[mt][nt][0], aF[mt][nt][1]), cvt_pk_bf16(aF[mt][nt][2], aF[mt][nt][3])}; }
    }
    __syncthreads();
}

DI void phase_scan(const Args& A) {
    bf16_t* KVS = (bf16_t*)(A.ws + OFF_KVS);
    for (int idx = blockIdx.x * 512 + threadIdx.x; idx < 2 * NB * RH * 8192; idx += gridDim.x * 512) {
        const int e4 = idx & 8191, h = (idx >> 13) & 3, b = (idx >> 15) & 1, dir = idx >> 16;
        const float lg = log2_sigmoid(dir ? A.dec_b[h] : A.dec_f[h]); const float cd = exp2f(128.f * lg);
        u32x2* p0 = (u32x2*)(KVS + kvs_off(dir, b, dir ? NCH - 1 : 0, h) + (size_t)e4 * 4);
        const long step = dir ? -(long)(RH * 32768 / 4) : (long)(RH * 32768 / 4);
        f32x4 S = (f32x4){0.f, 0.f, 0.f, 0.f};
        constexpr int BATCH0 = 33;
#pragma unroll 1
        for (int g = 0; g < 2; ++g) {
            const int cnt = g ? NCH - BATCH0 : BATCH0;
            u32x2 v[BATCH0];
            { u32x2* p = p0;
#pragma unroll
              for (int k = 0; k < BATCH0; ++k) { if (k < cnt) v[k] = *p; p += step; } }
            { u32x2* p = p0;
#pragma unroll
              for (int k = 0; k < BATCH0; ++k) { if (k < cnt) {
                *p = A.dry ? v[k] : (u32x2){cvt_pk_bf16(S[0], S[1]), cvt_pk_bf16(S[2], S[3])};
                S = S * cd + (f32x4){bflo(v[k].x), bfhi(v[k].x), bflo(v[k].y), bfhi(v[k].y)}; } p += step; } }
            p0 += (long)BATCH0 * step;
        }
    }
}

DI int swz(int r) { return ((r & 7) << 1) | ((r >> 3) & 1); }
DI void ret_out_unit(LAS unsigned char* lds, const Args& A, int b, int n, int h) {
    const int tid = threadIdx.x, lane = tid & 63, w = __builtin_amdgcn_readfirstlane(tid >> 6), fr = lane & 15, fq = lane >> 4;
    LAS unsigned char* KB = lds; LAS unsigned char* B1 = lds + 32768; LAS unsigned char* B2 = lds + 98304;
    const float lgf = log2_sigmoid(A.dec_f[h]), lgb = log2_sigmoid(A.dec_b[h]);
    const size_t row0 = (size_t)b * LP + (size_t)n * CH;
    const int i = 16 * w + fr;
    const int r4 = 4 * w + (lane >> 4), r2 = 2 * w + (lane >> 5);
    const unsigned offK = (unsigned)(r4 * 512 + (((lane & 15) ^ (r4 & 15)) << 3)) * 2u;
    const unsigned offV = (unsigned)(r2 * 1024 + (((lane & 31) ^ swz(r2)) << 3)) * 2u;
    const unsigned offS = (unsigned)(r4 * 128 + (((lane & 15) ^ (r4 & 15)) << 3)) * 2u;
    {
        const char* RK = (const char*)((const bf16_t*)(A.ws + OFF_RK) + row0 * 512 + h * 128);
        const char* RV = (const char*)((const bf16_t*)(A.ws + OFF_RV) + row0 * 1024 + h * 256);
#pragma unroll
        for (int k = 0; k < 4; ++k)
            __builtin_amdgcn_global_load_lds((const unsigned*)(RK + (size_t)k * 32 * 512 * 2 + offK), (LAS unsigned*)(KB + (8 * k + w) * 1024), 16, 0, 0);
#pragma unroll
        for (int k = 0; k < 8; ++k)
            __builtin_amdgcn_global_load_lds((const unsigned*)(RV + (size_t)k * 16 * 1024 * 2 + offV), (LAS unsigned*)(B1 + (8 * k + w) * 1024), 16, 0, 0);
    }
    bf16x8 q[4];
    { const bf16_t* qp = (const bf16_t*)(A.ws + OFF_RQ) + (row0 + i) * 512 + h * 128 + fq * 8;
#pragma unroll
      for (int ks = 0; ks < 4; ++ks) q[ks] = *(const bf16x8*)(qp + ks * 32); }
#define RET_DMA_STATE(dir_, dst_) do { const char* st_ = (const char*)((const bf16_t*)(A.ws + OFF_KVS) + kvs_off((dir_), b, n, h)); \
        _Pragma("unroll") for (int k_ = 0; k_ < 8; ++k_) \
            __builtin_amdgcn_global_load_lds((const unsigned*)(st_ + (size_t)k_ * 32 * 128 * 2 + offS), (LAS unsigned*)((dst_) + (8 * k_ + w) * 1024), 16, 0, 0); } while (0)
    asm volatile("s_waitcnt vmcnt(0)" ::: "memory");
    __syncthreads();
    RET_DMA_STATE(0, B2);
    const int kx = fr, koff = fr * 256;
    f32x4 S[8];
#pragma unroll
    for (int nt = 0; nt < 8; ++nt) S[nt] = (f32x4){0.f, 0.f, 0.f, 0.f};
#pragma unroll
    for (int ks = 0; ks < 4; ++ks)
#pragma unroll
        for (int nt = 0; nt < 8; ++nt) S[nt] = mfma16(*(const LAS bf16x8*)(KB + nt * 4096 + koff + (((4 * ks + fq) ^ kx) << 4)), q[ks], S[nt]);
    {
#pragma unroll
        for (int nt = 0; nt < 8; ++nt) {
            const int d0 = i - (16 * nt + 4 * fq);
#pragma unroll
            for (int e = 0; e < 4; ++e) { const int d = d0 - e; S[nt][e] *= d >= 0 ? __builtin_amdgcn_exp2f((float)d * lgf) : __builtin_amdgcn_exp2f((float)(-d) * lgb); }
        }
    }
    f32x4 O[16];
#pragma unroll
    for (int nt = 0; nt < 16; ++nt) O[nt] = (f32x4){0.f, 0.f, 0.f, 0.f};
    {
        const int tg = lane >> 4, tq = (lane & 15) >> 2, tp = lane & 3;
        const int vrow = 4 * tg + tq, vx = swz(vrow), voff = vrow * 512 + (tp & 1) * 8;
#pragma unroll
        for (int ks = 0; ks < 4; ++ks) {
            u32x4 w0;
            w0.x = cvt_pk_bf16(S[2 * ks][0], S[2 * ks][1]); w0.y = cvt_pk_bf16(S[2 * ks][2], S[2 * ks][3]);
            w0.z = cvt_pk_bf16(S[2 * ks + 1][0], S[2 * ks + 1][1]); w0.w = cvt_pk_bf16(S[2 * ks + 1][2], S[2 * ks + 1][3]);
            const bf16x8 p = __builtin_bit_cast(bf16x8, w0);
#pragma unroll
            for (int nt = 0; nt < 16; ++nt) {
                const LAS unsigned char* vp = B1 + ks * 16384 + voff + (((2 * nt + (tp >> 1)) ^ vx) << 4);
                const s16x4 lo = __builtin_amdgcn_ds_read_tr16_b64_v4i16((LAS s16x4*)vp);
                const s16x4 hi = __builtin_amdgcn_ds_read_tr16_b64_v4i16((LAS s16x4*)(vp + 8192));
                O[nt] = mfma16(__builtin_shufflevector(lo, hi, 0, 1, 2, 3, 4, 5, 6, 7), p, O[nt]); }
        }
    }
#pragma unroll
    for (int dir = 0; dir < 2; ++dir) {
        asm volatile("s_waitcnt vmcnt(0)" ::: "memory");
        __syncthreads();
        if (dir == 0) RET_DMA_STATE(1, B1);
        const LAS unsigned char* ST = dir ? B1 : B2;
        const float qs = dir ? __builtin_amdgcn_exp2f((float)(128 - i) * lgb) : __builtin_amdgcn_exp2f((float)(i + 1) * lgf);
#pragma unroll
        for (int ks = 0; ks < 4; ++ks) { const bf16x8 p = scale_frag(q[ks], qs);
#pragma unroll
            for (int nt = 0; nt < 16; ++nt) O[nt] = mfma16(*(const LAS bf16x8*)(ST + nt * 4096 + koff + (((4 * ks + fq) ^ kx) << 4)), p, O[nt]); }
    }
#undef RET_DMA_STATE
    float s = 0.f;
#pragma unroll
    for (int nt = 0; nt < 16; ++nt) s += (O[nt][0] + O[nt][1]) + (O[nt][2] + O[nt][3]);
    s += __shfl_xor(s, 16); s += __shfl_xor(s, 32);
    const float mu = s * (1.f / 256.f); float q2 = 0.f;
#pragma unroll
    for (int nt = 0; nt < 16; ++nt) { const f32x4 d = O[nt] - mu; q2 += (d[0] * d[0] + d[1] * d[1]) + (d[2] * d[2] + d[3] * d[3]); }
    q2 += __shfl_xor(q2, 16); q2 += __shfl_xor(q2, 32);
    const float rstd = rsqrtf(q2 * (1.f / 256.f) + EPSF);
    bf16_t* orow = (bf16_t*)(A.ws + OFF_OR) + ((size_t)b * SEQ + (size_t)(n - 1) * CH + i) * 1024 + h * 256;
    const float* nw = A.ret_nw + h * 256;
#pragma unroll
    for (int nt = 0; nt < 16; ++nt) { const f32x4 wv = *(const f32x4*)(nw + 16 * nt + 4 * fq); const f32x4 y = (O[nt] - mu) * rstd * wv;
        *(u32x2*)(orow + 16 * nt + 4 * fq) = (u32x2){cvt_pk_bf16(y[0], y[1]), cvt_pk_bf16(y[2], y[3])}; }
    __syncthreads();
}

struct AttnLane { int fr, fq, koff, kx, voff, vx, tp; };
DI void attn_sub(const LAS unsigned char* Ks, const LAS unsigned char* Vs, const bf16x8 (&q)[2][4], f32x4 (&O)[2][8], float (&mrun)[2], float (&lrun)[2], const int (&klo)[2], const int (&khi)[2], const AttnLane& L) {
    const float NEG = -1e30f;
    f32x4 S[2][4];
#pragma unroll
    for (int t = 0; t < 4; ++t) { S[0][t] = (f32x4){0.f, 0.f, 0.f, 0.f}; S[1][t] = (f32x4){0.f, 0.f, 0.f, 0.f}; }
#pragma unroll
    for (int ks = 0; ks < 4; ++ks)
#pragma unroll
        for (int t = 0; t < 4; ++t) { const bf16x8 kf = *(const LAS bf16x8*)(Ks + t * 4096 + L.koff + (((4 * ks + L.fq) ^ L.kx) << 4));
            S[0][t] = mfma16(kf, q[0][ks], S[0][t]); S[1][t] = mfma16(kf, q[1][ks], S[1][t]); }
#pragma unroll
    for (int mt = 0; mt < 2; ++mt) {
        float mx = NEG;
#pragma unroll
        for (int t = 0; t < 4; ++t) {
#pragma unroll
            for (int e = 0; e < 4; ++e) { const int jc = 16 * t + e; S[mt][t][e] = (jc >= klo[mt] && jc <= khi[mt]) ? S[mt][t][e] : NEG; }
            mx = fmaxf(fmaxf(mx, fmaxf(S[mt][t][0], S[mt][t][1])), fmaxf(S[mt][t][2], S[mt][t][3]));
        }
        mx = fmaxf(mx, __shfl_xor(mx, 16)); mx = fmaxf(mx, __shfl_xor(mx, 32));
        const float mnew = fmaxf(mrun[mt], mx), alpha = __builtin_amdgcn_exp2f(mrun[mt] - mnew);
        float rs = 0.f;
#pragma unroll
        for (int t = 0; t < 4; ++t)
#pragma unroll
            for (int e = 0; e < 4; ++e) { S[mt][t][e] = __builtin_amdgcn_exp2f(S[mt][t][e] - mnew); rs += S[mt][t][e]; }
        rs += __shfl_xor(rs, 16); rs += __shfl_xor(rs, 32);
        lrun[mt] = lrun[mt] * alpha + rs; mrun[mt] = mnew;
#pragma unroll
        for (int nt = 0; nt < 8; ++nt) O[mt][nt] = O[mt][nt] * alpha;
    }
#pragma unroll
    for (int ks = 0; ks < 2; ++ks) {
        u32x4 w0, w1;
        w0.x = cvt_pk_bf16(S[0][2 * ks][0], S[0][2 * ks][1]); w0.y = cvt_pk_bf16(S[0][2 * ks][2], S[0][2 * ks][3]);
        w0.z = cvt_pk_bf16(S[0][2 * ks + 1][0], S[0][2 * ks + 1][1]); w0.w = cvt_pk_bf16(S[0][2 * ks + 1][2], S[0][2 * ks + 1][3]);
        w1.x = cvt_pk_bf16(S[1][2 * ks][0], S[1][2 * ks][1]); w1.y = cvt_pk_bf16(S[1][2 * ks][2], S[1][2 * ks][3]);
        w1.z = cvt_pk_bf16(S[1][2 * ks + 1][0], S[1][2 * ks + 1][1]); w1.w = cvt_pk_bf16(S[1][2 * ks + 1][2], S[1][2 * ks + 1][3]);
        const bf16x8 p0 = __builtin_bit_cast(bf16x8, w0), p1 = __builtin_bit_cast(bf16x8, w1);
#pragma unroll
        for (int nt = 0; nt < 8; ++nt) {
            const LAS unsigned char* vp = Vs + ks * 8192 + L.voff + (((2 * nt + (L.tp >> 1)) ^ L.vx) << 4);
            const s16x4 lo = __builtin_amdgcn_ds_read_tr16_b64_v4i16((LAS s16x4*)vp);
            const s16x4 hi = __builtin_amdgcn_ds_read_tr16_b64_v4i16((LAS s16x4*)(vp + 4096));
            const bf16x8 vf = __builtin_shufflevector(lo, hi, 0, 1, 2, 3, 4, 5, 6, 7);
            O[0][nt] = mfma16(vf, p0, O[0][nt]); O[1][nt] = mfma16(vf, p1, O[1][nt]); }
    }
}
DI void attn_unit(LAS unsigned char* lds, const Args& A, int b, int g, int n, int half) {
    const int tid = threadIdx.x, lane = tid & 63, w = __builtin_amdgcn_readfirstlane(tid >> 6), fr = lane & 15, fq = lane >> 4;
    const int head = g * 4 + (w >> 1), rbase = 64 * half + 32 * (w & 1);
    const float sinkl = A.sink[head] * LOG2E;
    f32x4 O[2][8]; float mrun[2], lrun[2];
#pragma unroll
    for (int mt = 0; mt < 2; ++mt) { mrun[mt] = sinkl; lrun[mt] = 1.f;
#pragma unroll
        for (int nt = 0; nt < 8; ++nt) O[mt][nt] = (f32x4){0.f, 0.f, 0.f, 0.f}; }
    const size_t qrow0 = (size_t)b * LP + (size_t)n * CH;
    bf16x8 q[2][4];
    { const bf16_t* AQ = (const bf16_t*)(A.ws + OFF_AQ) + (qrow0 + rbase + fr) * 1024 + head * 128 + fq * 8;
#pragma unroll
      for (int mt = 0; mt < 2; ++mt)
#pragma unroll
          for (int ks = 0; ks < 4; ++ks) q[mt][ks] = *(const bf16x8*)(AQ + (size_t)(16 * mt) * 1024 + ks * 32); }
    const unsigned vm = (n >= 2 ? 1u : 0u) | 2u | (n <= NCH - 2 ? 4u : 0u) | 8u;
    const char* AKb = (const char*)((const bf16_t*)(A.ws + OFF_AK) + (size_t)b * LP * 256 + g * 128);
    const char* AVb = (const char*)((const bf16_t*)(A.ws + OFF_AV) + (size_t)b * LP * 256 + g * 128);
    const int r4 = 4 * w + (lane >> 4);
    const unsigned offK = (unsigned)(r4 * 256 + (((lane & 15) ^ (r4 & 15)) << 3)) * 2u, offV = (unsigned)(r4 * 256 + (((lane & 15) ^ swz(r4)) << 3)) * 2u;
#define ATT_DMA(kt_, buf_) do { const size_t kr_ = (size_t)((kt_) == 3 ? 0 : n - 1 + (kt_)) * CH * 256 * 2; \
        _Pragma("unroll") for (int i_ = 0; i_ < 4; ++i_) { \
            __builtin_amdgcn_global_load_lds((const unsigned*)(AKb + kr_ + (size_t)i_ * 32 * 256 * 2 + offK), (LAS unsigned*)(lds + (buf_) * 65536 + (8 * i_ + w) * 1024), 16, 0, 0); \
            __builtin_amdgcn_global_load_lds((const unsigned*)(AVb + kr_ + (size_t)i_ * 32 * 256 * 2 + offV), (LAS unsigned*)(lds + (buf_) * 65536 + 32768 + (8 * i_ + w) * 1024), 16, 0, 0); } } while (0)
    AttnLane L; L.fr = fr; L.fq = fq; L.koff = fr * 256; L.kx = fr; L.tp = lane & 3;
    { const int vrow = 4 * (lane >> 4) + ((lane & 15) >> 2); L.vx = swz(vrow); L.voff = vrow * 256 + (L.tp & 1) * 8; }
    int kt = __builtin_ctz(vm), buf = 0;
    ATT_DMA(kt, 0);
#pragma unroll 1
    for (;;) {
        asm volatile("s_waitcnt vmcnt(0)" ::: "memory");
        __syncthreads();
        const unsigned rest = vm >> (kt + 1);
        const int ktn = rest ? kt + 1 + __builtin_ctz(rest) : -1;
        if (ktn >= 0) ATT_DMA(ktn, buf ^ 1);
        const LAS unsigned char* Kt = lds + buf * 65536; const LAS unsigned char* Vt = Kt + 32768;
        const int slo = (kt == 3 || (kt == 0 && rbase >= 64)) ? 1 : 0;
        const int shi = (kt == 2 && rbase < 64) ? 1 : 2;
#pragma unroll 1
        for (int sub = slo; sub < shi; ++sub) {
            int klo[2], khi[2];
#pragma unroll
            for (int mt = 0; mt < 2; ++mt) { const int ii = rbase + 16 * mt + fr;
                klo[mt] = (kt == 0 ? ii : kt == 3 ? MPAD : 0) - 64 * sub - 4 * fq; khi[mt] = (kt == 2 ? ii : 127) - 64 * sub - 4 * fq; }
            attn_sub(Kt + sub * 16384, Vt + sub * 16384, q, O, mrun, lrun, klo, khi, L);
        }
        if (ktn < 0) break;
        kt = ktn; buf ^= 1;
    }
#undef ATT_DMA
    bf16_t* OA = (bf16_t*)(A.ws + OFF_OA) + ((size_t)b * SEQ + (size_t)(n - 1) * CH) * 1024 + head * 128;
#pragma unroll
    for (int mt = 0; mt < 2; ++mt) { const float inv = 1.f / lrun[mt]; const int ii = rbase + 16 * mt + fr;
#pragma unroll
        for (int nt = 0; nt < 8; ++nt) { const f32x4 y = O[mt][nt] * inv;
            *(u32x2*)(OA + (size_t)ii * 1024 + 16 * nt + 4 * fq) = (u32x2){cvt_pk_bf16(y[0], y[1]), cvt_pk_bf16(y[2], y[3])}; } }
    __syncthreads();
}

DI void phase_final(const Args& A) {
    const int tid = threadIdx.x, lane = tid & 63, wave = tid >> 6;
    const float* OUT = (const float*)(A.ws + OFF_OUT);
    for (int r = blockIdx.x * 8 + wave; r < MS; r += gridDim.x * 8) {
        const f32x4* o4 = (const f32x4*)(OUT + (size_t)r * DM) + lane; const f32x4* x4 = (const f32x4*)(A.x + (size_t)r * DM) + lane;
        const f32x4* w4 = (const f32x4*)A.post_w + lane; f32x4* d4 = (f32x4*)(A.out + (size_t)r * DM) + lane;
        f32x4 v[4]; float s = 0.f;
#pragma unroll
        for (int j = 0; j < 4; ++j) { v[j] = o4[64 * j]; s += (v[j][0] * v[j][0] + v[j][1] * v[j][1]) + (v[j][2] * v[j][2] + v[j][3] * v[j][3]); }
        const float rs = rsqrtf(wave_sum(s) * (1.f / DM) + EPSF);
#pragma unroll
        for (int j = 0; j < 4; ++j) d4[64 * j] = x4[64 * j] + v[j] * rs * w4[64 * j];
    }
}


#define XB_TMO      128
#define XB_XCNT(j)  (256  + 64 * (j))
#define XB_XSUB(j)  (1280 + 64 * (j))
#define XB_XGEN(j)  (2304 + 64 * (j))
#define XB_TOP      3328
#define XB_TOPGEN   3392
#define XCD_BAR_WORDS 3456
#define XB_SPIN_CAP (1u << 18)
DI unsigned xb_ld(unsigned* p)              { return __hip_atomic_load(p, __ATOMIC_RELAXED, __HIP_MEMORY_SCOPE_AGENT); }
DI unsigned xb_add(unsigned* p, unsigned v) { return __hip_atomic_fetch_add(p, v, __ATOMIC_RELAXED, __HIP_MEMORY_SCOPE_AGENT); }
DI unsigned xb_xcc_id() { return (unsigned)__builtin_amdgcn_s_getreg((3 << 11) | 20) & 0xFu; }
#define XB_SPIN(cond, bar) do { unsigned _sp = 0; while (cond) { __builtin_amdgcn_s_sleep(1); \
    if ((++_sp & 255u) == 0u) { if (xb_ld(&(bar)[XB_TMO])) break; if (_sp > XB_SPIN_CAP) { atomicAdd(&(bar)[XB_TMO], 1u); break; } } } } while (0)
struct XcdBarrier { unsigned* bar; unsigned x; volatile unsigned* st; };
DI XcdBarrier xcd_barrier_post(unsigned* bar, volatile unsigned* st) {
    XcdBarrier b; b.bar = bar; b.x = xb_xcc_id(); b.st = st;
    if (threadIdx.x == 0) (void)xb_add(&bar[XB_XCNT(b.x)], 1u);
    return b;
}
DI void xcd_barrier_complete(unsigned* bar, unsigned x, unsigned& nloc, unsigned& nx) {
    const unsigned G = gridDim.x * gridDim.y * gridDim.z;
    unsigned sum, cnt, mine, sp = 0u;
    for (;;) {
        sum = 0u; cnt = 0u; mine = 0u;
#pragma unroll
        for (unsigned j = 0; j < 16; ++j) { const unsigned c = xb_ld(&bar[XB_XCNT(j)]); sum += c; cnt += (c > 0u) ? 1u : 0u; mine = (j == x) ? c : mine; }
        if (sum == G) break;
        __builtin_amdgcn_s_sleep(1);
        if ((++sp & 255u) == 0u) { if (xb_ld(&bar[XB_TMO])) break; if (sp > XB_SPIN_CAP) { atomicAdd(&bar[XB_TMO], 1u); break; } }
    }
    nloc = mine > 0u ? mine : 1u; nx = cnt > 0u ? cnt : 1u;
}
DI void xcd_barrier(const XcdBarrier& b) {
    asm volatile("s_waitcnt vmcnt(0)" ::: "memory");
    __syncthreads();
    if (threadIdx.x == 0) {
        unsigned* bar = b.bar;
        __builtin_amdgcn_s_waitcnt(0);
        unsigned nloc = b.st[0], nx = b.st[1];
        if (nloc == 0u) { xcd_barrier_complete(bar, b.x, nloc, nx); b.st[0] = nloc; b.st[1] = nx; }
        const unsigned old = xb_add(&bar[XB_XSUB(b.x)], 1u);
        const unsigned gen = old / nloc;
        if (old + 1u == (gen + 1u) * nloc) {
            __builtin_amdgcn_fence(__ATOMIC_RELEASE, "agent");
            asm volatile("s_waitcnt vmcnt(0)" ::: "memory");
            const unsigned og = xb_add(&bar[XB_TOP], 1u);
            const unsigned tg = og / nx;
            if (og + 1u == (tg + 1u) * nx) xb_add(&bar[XB_TOPGEN], 1u);
            else XB_SPIN(xb_ld(&bar[XB_TOPGEN]) == tg, bar);
            __builtin_amdgcn_fence(__ATOMIC_ACQUIRE, "agent");
            xb_add(&bar[XB_XGEN(b.x)], 1u);
            asm volatile("s_waitcnt vmcnt(0)" ::: "memory");
        } else {
            XB_SPIN(xb_ld(&bar[XB_XGEN(b.x)]) == gen, bar);
            __builtin_amdgcn_fence(__ATOMIC_ACQUIRE, "agent");
            asm volatile("s_waitcnt vmcnt(0)" ::: "memory");
        }
    }
    __syncthreads();
}

constexpr int NPHASE = 9;
__global__ void __launch_bounds__(512, 2) fwd_kernel(Args A) {
    extern __shared__ __attribute__((aligned(16))) unsigned char lds_raw[];
    LAS unsigned char* lds = (LAS unsigned char*)lds_raw;
    const int lo = A.ph_lo, hi = A.ph_hi, G = gridDim.x, bx = blockIdx.x;
    unsigned char* dob = (unsigned char*)A.out;
    volatile unsigned* bst = (volatile unsigned*)(A.ws + OFF_CTL) + 8192 + 2 * blockIdx.x;
    XcdBarrier bar; bar.bar = (unsigned*)(A.ws + OFF_CTL); bar.x = 0; bar.st = bst;
    if (hi - lo > 1) bar = xcd_barrier_post((unsigned*)(A.ws + OFF_CTL), bst);
    if (lo < 0) cg::this_grid().sync();
#ifndef PH_MASK
#define PH_MASK 0x3ff
#endif
#define IN(k) (((PH_MASK >> (k)) & 1) && lo <= (k) && (k) < hi)
#ifndef DUP_MASK
#define DUP_MASK 0
#endif
#define REP(k) _Pragma("unroll 1") for (int rep_ = 0; rep_ < (((DUP_MASK) >> (k)) & 1) + 1; ++rep_)
#define SEAM(k) do { if (IN(k) && IN((k) + 1)) xcd_barrier(bar); } while (0)
    if (IN(0)) REP(0) { phase_prologue(lds, A); __syncthreads(); }
    SEAM(0);
    if (IN(1)) REP(1) {
        pg8::Gemm g{(const bf16_t*)(dob + DO_U), (const bf16_t*)(dob + DO_WIN), MP, NA, DM, 0}; pg8::StaticOrder S; S.init(MP, NA, G, bx);
        EpiA E{A.ws, (const float*)(dob + DO_CS)};
        pg8::gemm_phase<EpiA, true>(lds, g, S, E);
    }
    SEAM(1);
    if (IN(2)) REP(2) {
        for (int u = bx; u < 2 * NB * AG * (NCH - 1); u += G) { const int half = u & 1, v = u >> 1, n = 1 + v % (NCH - 1), bg = v / (NCH - 1); attn_unit(lds, A, bg >> 1, bg & 1, n, half); }
        if (!A.dry) for (int u = bx; u < NB * NCH * RH; u += G) { const int h = u & 3, bn = u >> 2; ret_kv_unit(lds, A, bn / NCH, bn % NCH, h); }
    }
    SEAM(2);
    if (IN(3)) REP(3) phase_scan(A);
    SEAM(3);
    if (IN(4)) REP(4) {
        for (int u = bx; u < NB * (NCH - 1) * RH; u += G) { const int h = u & 3, bn = u >> 2; ret_out_unit(lds, A, bn / (NCH - 1), 1 + bn % (NCH - 1), h); }
    }
    SEAM(4);
    if (IN(5)) REP(5) {
        pg8::Gemm g{(const bf16_t*)(dob + DO_U), (const bf16_t*)(dob + DO_WIN) + (size_t)NA * DM, MS, NGATE, DM, 1}; pg8::StaticOrder S; S.init(MS, NGATE, G, bx);
        EpiGate E{A.ws, A.dry};
        pg8::gemm_phase<EpiGate, true>(lds, g, S, E);
    }
    SEAM(5);
    if (IN(6)) REP(6) {
        pg8::Gemm g{(const bf16_t*)(A.ws + OFF_OR), (const bf16_t*)(dob + DO_WRB), MS, DM, DM, 0}; pg8::StaticOrder S; S.init(MS, DM, G, bx);
        EpiPost<0> E{A.ws};
        pg8::gemm_phase<EpiPost<0>, false>(lds, g, S, E);
    }
    if (IN(6) && IN(7)) __syncthreads();
    if (IN(7)) REP(7) {
        pg8::Gemm g{(const bf16_t*)(A.ws + OFF_OA), (const bf16_t*)(dob + DO_WAB), MS, DM, DM, 0}; pg8::StaticOrder S; S.init(MS, DM, G, bx);
        EpiPost<1> E{A.ws};
        pg8::gemm_phase<EpiPost<1>, false>(lds, g, S, E);
    }
    SEAM(7);
    if (IN(8)) REP(8) {
        pg8::Gemm g{(const bf16_t*)(A.ws + OFF_MIX), (const bf16_t*)(A.ws + OFF_WO), MS, DM, DM, 0}; pg8::StaticOrder S; S.init(MS, DM, G, bx);
        EpiOutNorm E{A.x, A.post_w, A.out, (float*)(A.ws + OFF_XBUF), (unsigned*)(A.ws + OFF_CTL) + 4096};
        pg8::gemm_phase<EpiOutNorm, false>(lds, g, S, E);
    }
#undef IN
#undef SEAM
}

extern "C" void kernel_launch(void* const* d_in, const int* in_sizes, int n_in, void* d_out, int out_size, void* d_ws, size_t ws_size, hipStream_t stream) {
    static int grid = 0;
    if (grid == 0) {
        if (n_in != 12 || out_size != MS * DM || ws_size < WS_NEED) { fprintf(stderr, "kernel_launch: unexpected shapes (n_in %d out %d ws %zu)\n", n_in, out_size, ws_size); grid = -1; return; }
        int dev = 0, cus = 0, per_cu = 0;
        hipGetDevice(&dev); hipDeviceGetAttribute(&cus, hipDeviceAttributeMultiprocessorCount, dev);
        if (hipFuncSetAttribute((const void*)fwd_kernel, hipFuncAttributeMaxDynamicSharedMemorySize, LDS_BYTES) != hipSuccess) { fprintf(stderr, "kernel_launch: hipFuncSetAttribute failed\n"); grid = -1; return; }
        hipOccupancyMaxActiveBlocksPerMultiprocessor(&per_cu, (const void*)fwd_kernel, 512, LDS_BYTES);
        (void)hipGetLastError();
        if (per_cu < 1) { fprintf(stderr, "kernel_launch: occupancy query says %d blocks per CU\n", per_cu); per_cu = 1; }
        grid = cus;
    }
    if (grid < 0) return;
    Args a{};
    a.x = (const float*)d_in[0]; a.meta = (const float*)d_in[1]; a.pre_w = (const float*)d_in[2]; a.w_in = (const float*)d_in[3];
    a.dec_f = (const float*)d_in[4]; a.dec_b = (const float*)d_in[5]; a.ret_nw = (const float*)d_in[6]; a.w_rb = (const float*)d_in[7];
    a.sink = (const float*)d_in[8]; a.w_ab = (const float*)d_in[9]; a.w_o = (const float*)d_in[10]; a.post_w = (const float*)d_in[11];
    a.out = (float*)d_out; a.ws = (unsigned char*)d_ws;
    if (hipMemsetAsync((char*)d_ws + OFF_CTL, 0, CTL_BYTES, stream) != hipSuccess) { fprintf(stderr, "kernel_launch: memset failed\n"); return; }
#if MK_N_LAUNCHES == 1
    a.ph_lo = 0; a.ph_hi = NPHASE;
    void* args[] = {&a};
    hipError_t e = hipLaunchCooperativeKernel((const void*)fwd_kernel, dim3(grid), dim3(512), args, LDS_BYTES, stream);
    if (e != hipSuccess) fprintf(stderr, "cooperative launch failed: %s (grid %d)\n", hipGetErrorString(e), grid);
#else
    for (int p = 0; p < NPHASE; ++p) {
        if (p == 7) continue;
        a.ph_lo = p; a.ph_hi = (p == 6) ? 8 : p + 1;
        for (int rep = 0; rep < ((HDUP_MASK >> p) & 1) + 1; ++rep) { a.dry = (rep == 0 && ((HDUP_MASK >> p) & 1)) ? 1 : 0;
        hipLaunchKernelGGL(fwd_kernel, dim3(grid), dim3(512), LDS_BYTES, stream, a); }
    }
#endif
}
```
